# Optimizing an MI355X kernel written in HIP

```python
import jax, jax.numpy as jnp
from jax import lax
import numpy as np

D_MODEL = 1024
BATCH = 8
SEQ = 4096
DEPTH = 1
DEC_BATCH = 128
DEC_SEQ = 8
PAST_LEN = 16384
PAGE_SIZE = 128

HEAD_DIM = 64
SWA_HEADS = 8
SWA_KV_HEADS = 2
SWA_GROUP = SWA_HEADS // SWA_KV_HEADS
WINDOW = 128
RET_HEADS = 8
RET_DIM = 64
RET_CHUNK = 128
RET_THETA = 10000.0
MEM_LEN = 256
MEM_HEADS = 4
MEM_HEAD_DIM = 128
MEM_W = MEM_HEADS * MEM_HEAD_DIM
FFN_HIDDEN = ((8 * D_MODEL + 3 * 256 - 1) // (3 * 256)) * 256
ROPE_THETA = 10000.0
RMS_EPS = 1e-6
NEG_INF = -1e30
SWA_Q_W = SWA_HEADS * HEAD_DIM
SWA_KV_W = SWA_KV_HEADS * HEAD_DIM
RET_W = RET_HEADS * RET_DIM
IN_COLS = SWA_Q_W + 2 * SWA_KV_W + 4 * RET_W
MIX_WIDTH = SWA_Q_W + RET_W

kernel_name = 'hymba_swa_sink_retention_memxattn_step'


def rms_norm(x, g=None):
    xf = x.astype(jnp.float32)
    y = xf * lax.rsqrt(jnp.mean(xf * xf, axis=-1, keepdims=True) + RMS_EPS)
    if g is not None:
        y = y * g.astype(jnp.float32)
    return y.astype(x.dtype)


def rotary(x, pos):
    half = x.shape[-1] // 2
    inv = 1.0 / (ROPE_THETA ** (jnp.arange(half, dtype=jnp.float32) / half))
    ang = pos.astype(jnp.float32)[:, None] * inv[None, :]
    cos = jnp.cos(ang)[:, None, :]
    sin = jnp.sin(ang)[:, None, :]
    xf = x.astype(jnp.float32)
    x1, x2 = xf[..., :half], xf[..., half:]
    return jnp.concatenate([x1 * cos - x2 * sin, x2 * cos + x1 * sin], axis=-1).astype(x.dtype)


def retention_rotate(x, pos):
    half = x.shape[-1] // 2
    inv = RET_THETA ** (-jnp.linspace(0.0, 1.0, half, dtype=jnp.float32))
    ang = pos.astype(jnp.float32)[:, None] * inv[None, :]
    cos = jnp.cos(ang)[:, None, :]
    sin = jnp.sin(ang)[:, None, :]
    xf = x.astype(jnp.float32)
    xe, xo = xf[..., 0::2], xf[..., 1::2]
    out = jnp.stack([xe * cos - xo * sin, xo * cos + xe * sin], axis=-1)
    return out.reshape(x.shape).astype(x.dtype)


def window_mask(q_pos, k_pos):
    d = q_pos - k_pos
    return (k_pos >= 0) & (d >= 0) & (d < WINDOW)


def sink_attention(q, k, v, sinks, mask):
    s = jnp.einsum('...qhgd,...khd->...hgqk', q, k).astype(jnp.float32) * (HEAD_DIM ** -0.5)
    s = jnp.where(mask[..., None, None, :, :], s, NEG_INF)
    sink = sinks.astype(jnp.float32).reshape(SWA_KV_HEADS, SWA_GROUP, 1, 1)
    m = jnp.maximum(jnp.max(s, axis=-1, keepdims=True), sink)
    p = jnp.exp(s - m)
    denom = jnp.sum(p, axis=-1, keepdims=True) + jnp.exp(sink - m)
    w = (p / denom).astype(v.dtype)
    return jnp.einsum('...hgqk,...khd->...qhgd', w, v)


def swa_prompt(q, k, v, sinks):
    B, L, H, D = q.shape
    nb = L // WINDOW
    qb = q.reshape(B, nb, WINDOW, SWA_KV_HEADS, SWA_GROUP, D)
    kb = k.reshape(B, nb, WINDOW, SWA_KV_HEADS, D)
    vb = v.reshape(B, nb, WINDOW, SWA_KV_HEADS, D)
    prev = lambda t: jnp.concatenate([jnp.zeros_like(t[:, :1]), t[:, :-1]], axis=1)
    kk = jnp.concatenate([prev(kb), kb], axis=2)
    vv = jnp.concatenate([prev(vb), vb], axis=2)
    start = jnp.arange(nb, dtype=jnp.int32)[:, None] * WINDOW
    q_pos = start + jnp.arange(WINDOW, dtype=jnp.int32)[None, :]
    k_pos = start - WINDOW + jnp.arange(2 * WINDOW, dtype=jnp.int32)[None, :]
    mask = window_mask(q_pos[:, :, None], k_pos[:, None, :])
    o = sink_attention(qb, kk, vv, sinks, mask)
    return o.reshape(B, L, H, D), k[:, -WINDOW:], v[:, -WINDOW:]


def swa_sample(q, k, v, sinks, buf_k, buf_v):
    B, T, H, D = q.shape
    nbuf = buf_k.shape[1]
    kk = jnp.concatenate([buf_k.astype(k.dtype), k], axis=1)
    vv = jnp.concatenate([buf_v.astype(v.dtype), v], axis=1)
    q_pos = PAST_LEN + jnp.arange(T, dtype=jnp.int32)
    k_pos = PAST_LEN - nbuf + jnp.arange(nbuf + T, dtype=jnp.int32)
    mask = window_mask(q_pos[:, None], k_pos[None, :])
    o = sink_attention(q.reshape(B, T, SWA_KV_HEADS, SWA_GROUP, D), kk, vv, sinks, mask)
    return o.reshape(B, T, H, D), kk[:, -nbuf:], vv[:, -nbuf:]


def retention(q, k, v, s0):
    B, L, H, D = q.shape
    Dv = v.shape[-1]
    c = RET_CHUNK if L % RET_CHUNK == 0 else L
    n = L // c
    log_g = jnp.log(1.0 - jnp.exp2(-5.0 - jnp.arange(H, dtype=jnp.float32)))
    idx = jnp.arange(c, dtype=jnp.float32)
    diff = idx[:, None] - idx[None, :]
    dmat = jnp.where(diff >= 0, jnp.exp(jnp.maximum(diff, 0.0)[None] * log_g[:, None, None]), 0.0)
    q_decay = jnp.exp((idx + 1.0)[None, :] * log_g[:, None]).T[None, :, :, None]
    k_decay = jnp.exp((c - 1.0 - idx)[None, :] * log_g[:, None])
    chunk_decay = jnp.exp(c * log_g)[None, :, None, None]
    to_chunks = lambda t: t.astype(jnp.float32).reshape(B, n, c, H, t.shape[-1]).swapaxes(0, 1)

    def step(s, inp):
        qi, ki, vi = inp
        inner = jnp.einsum('bqhd,bkhd->bhqk', qi, ki) * dmat[None]
        o = jnp.einsum('bhqk,bkhe->bqhe', inner, vi) + jnp.einsum('bqhd,bhde->bqhe', qi, s) * q_decay
        s_new = s * chunk_decay + jnp.einsum('bkhd,bkhe,hk->bhde', ki, vi, k_decay)
        return s_new, o

    s, o = lax.scan(step, s0.astype(jnp.float32), (to_chunks(q), to_chunks(k), to_chunks(v)))
    return o.swapaxes(0, 1).reshape(B, L, H, Dv), s


def parallel_mixer(h, pos, swa_fn, s0, w_in, q_norm_a, k_norm_a, sinks, w_out):
    B, L, _ = h.shape
    proj = h @ w_in
    cuts = [SWA_Q_W, SWA_Q_W + SWA_KV_W, SWA_Q_W + 2 * SWA_KV_W]
    cuts = cuts + [cuts[-1] + RET_W, cuts[-1] + 2 * RET_W, cuts[-1] + 3 * RET_W]
    qa, ka, va, qr, kr, vr, g = jnp.split(proj, cuts, axis=-1)
    qa = rotary(rms_norm(qa.reshape(B, L, SWA_HEADS, HEAD_DIM), q_norm_a), pos)
    ka = rotary(rms_norm(ka.reshape(B, L, SWA_KV_HEADS, HEAD_DIM), k_norm_a), pos)
    va = va.reshape(B, L, SWA_KV_HEADS, HEAD_DIM)
    o_a, k_new, v_new = swa_fn(qa, ka, va, sinks)
    qr = retention_rotate(qr.reshape(B, L, RET_HEADS, RET_DIM), pos)
    kr = retention_rotate(kr.reshape(B, L, RET_HEADS, RET_DIM), pos) * (RET_DIM ** -0.5)
    vr = vr.reshape(B, L, RET_HEADS, RET_DIM)
    o_r, s_new = retention(qr, kr, vr, s0)
    o_r = rms_norm(o_r).astype(h.dtype).reshape(B, L, RET_W) * jax.nn.silu(g)
    y = jnp.concatenate([o_a.reshape(B, L, SWA_Q_W), o_r], axis=-1) @ w_out
    return y, k_new, v_new, s_new


def memory_kv(mem, norm_mem, w_mkv, k_norm_m):
    B, M, _ = mem.shape
    kv = rms_norm(mem, norm_mem) @ w_mkv
    k, v = jnp.split(kv, 2, axis=-1)
    k = rms_norm(k.reshape(B, M, MEM_HEADS, MEM_HEAD_DIM), k_norm_m)
    return k, v.reshape(B, M, MEM_HEADS, MEM_HEAD_DIM)


def memory_cross(h, mem_k, mem_v, w_mq, q_norm_m, w_mo):
    B, L, _ = h.shape
    q = rms_norm((h @ w_mq).reshape(B, L, MEM_HEADS, MEM_HEAD_DIM), q_norm_m)
    s = jnp.einsum('blhd,bmhd->bhlm', q, mem_k.astype(q.dtype)).astype(jnp.float32) * (MEM_HEAD_DIM ** -0.5)
    p = jax.nn.softmax(s, axis=-1).astype(h.dtype)
    o = jnp.einsum('bhlm,bmhd->blhd', p, mem_v.astype(h.dtype)).reshape(B, L, MEM_W)
    return o @ w_mo


def swiglu(h, w_gu, w_down):
    g, u = jnp.split(h @ w_gu, 2, axis=-1)
    return (jax.nn.silu(g) * u) @ w_down


def decoder_layer(x, pos, swa_fn, s0, mem_k, mem_v, norm_mix, w_in, q_norm_a, k_norm_a, sinks, w_out,
                  norm_cross, w_mq, q_norm_m, w_mo, norm_ffn, w_gu, w_down):
    y, k_new, v_new, s_new = parallel_mixer(rms_norm(x, norm_mix), pos, swa_fn, s0,
                                            w_in, q_norm_a, k_norm_a, sinks, w_out)
    x = x + y
    x = x + memory_cross(rms_norm(x, norm_cross), mem_k, mem_v, w_mq, q_norm_m, w_mo)
    x = x + swiglu(rms_norm(x, norm_ffn), w_gu, w_down)
    return x, k_new, v_new, s_new


def setup_inputs(seed: int = 0) -> dict:
    key = jax.random.key(seed)
    ks = jax.random.split(key, 24)
    f32 = jnp.float32
    nrm = lambda k, shape, scale: jax.random.normal(k, shape, f32) * scale
    gain = lambda k, n: 1.0 + 0.02 * jax.random.normal(k, (DEPTH, n), f32)
    buf = min(WINDOW, PAST_LEN)
    return {
        'x_prompt': nrm(ks[0], (BATCH, SEQ, D_MODEL), 1.0),
        'x_sample': nrm(ks[1], (DEC_BATCH, DEC_SEQ, D_MODEL), 1.0),
        'mem_prompt': nrm(ks[2], (BATCH, MEM_LEN, D_MODEL), 1.0),
        'cache_swa_k': nrm(ks[3], (DEPTH, DEC_BATCH, buf, SWA_KV_HEADS, HEAD_DIM), 1.0),
        'cache_swa_v': nrm(ks[4], (DEPTH, DEC_BATCH, buf, SWA_KV_HEADS, HEAD_DIM), 1.0),
        'state_ret': nrm(ks[5], (DEPTH, DEC_BATCH, RET_HEADS, RET_DIM, RET_DIM), 0.5),
        'cache_mem_k': nrm(ks[6], (DEPTH, DEC_BATCH, MEM_LEN, MEM_HEADS, MEM_HEAD_DIM), 1.0),
        'cache_mem_v': nrm(ks[7], (DEPTH, DEC_BATCH, MEM_LEN, MEM_HEADS, MEM_HEAD_DIM), 1.0),
        'norm_mix': gain(ks[8], D_MODEL),
        'w_in': nrm(ks[9], (DEPTH, D_MODEL, IN_COLS), D_MODEL ** -0.5),
        'q_norm_a': gain(ks[10], HEAD_DIM),
        'k_norm_a': gain(ks[11], HEAD_DIM),
        'sinks': nrm(ks[12], (DEPTH, SWA_HEADS), 1.0),
        'w_out': nrm(ks[13], (DEPTH, MIX_WIDTH, D_MODEL), MIX_WIDTH ** -0.5),
        'norm_cross': gain(ks[14], D_MODEL),
        'norm_mem': gain(ks[15], D_MODEL),
        'w_mq': nrm(ks[16], (DEPTH, D_MODEL, MEM_W), D_MODEL ** -0.5),
        'w_mkv': nrm(ks[17], (DEPTH, D_MODEL, 2 * MEM_W), D_MODEL ** -0.5),
        'q_norm_m': gain(ks[18], MEM_HEAD_DIM),
        'k_norm_m': gain(ks[19], MEM_HEAD_DIM),
        'w_mo': nrm(ks[20], (DEPTH, MEM_W, D_MODEL), MEM_W ** -0.5),
        'norm_ffn': gain(ks[21], D_MODEL),
        'w_gu': nrm(ks[22], (DEPTH, D_MODEL, 2 * FFN_HIDDEN), D_MODEL ** -0.5),
        'w_down': nrm(ks[23], (DEPTH, FFN_HIDDEN, D_MODEL), FFN_HIDDEN ** -0.5),
    }


def reference(x_prompt, x_sample, mem_prompt, cache_swa_k, cache_swa_v, state_ret, cache_mem_k, cache_mem_v,
              norm_mix, w_in, q_norm_a, k_norm_a, sinks, w_out, norm_cross, norm_mem, w_mq, w_mkv,
              q_norm_m, k_norm_m, w_mo, norm_ffn, w_gu, w_down):
    pos_p = jnp.arange(x_prompt.shape[1], dtype=jnp.int32)
    pos_s = PAST_LEN + jnp.arange(x_sample.shape[1], dtype=jnp.int32)
    xp, xs = x_prompt, x_sample
    pk, pv, ps, pmk, pmv, sk, sv, ss = [], [], [], [], [], [], [], []
    for l in range(DEPTH):
        lw = (norm_mix[l], w_in[l], q_norm_a[l], k_norm_a[l], sinks[l], w_out[l],
              norm_cross[l], w_mq[l], q_norm_m[l], w_mo[l], norm_ffn[l], w_gu[l], w_down[l])
        mk, mv = memory_kv(mem_prompt, norm_mem[l], w_mkv[l], k_norm_m[l])
        s0 = jnp.zeros((xp.shape[0], RET_HEADS, RET_DIM, RET_DIM), jnp.float32)
        xp, k_new, v_new, s_new = decoder_layer(xp, pos_p, swa_prompt, s0, mk, mv, *lw)
        pk.append(k_new); pv.append(v_new); ps.append(s_new); pmk.append(mk); pmv.append(mv)
        fn = lambda q, k, v, sk_, bk=cache_swa_k[l], bv=cache_swa_v[l]: swa_sample(q, k, v, sk_, bk, bv)
        xs, k_new, v_new, s_new = decoder_layer(xs, pos_s, fn, state_ret[l], cache_mem_k[l], cache_mem_v[l], *lw)
        sk.append(k_new); sv.append(v_new); ss.append(s_new)
    return (xp, xs, jnp.stack(pk), jnp.stack(pv), jnp.stack(ps), jnp.stack(pmk), jnp.stack(pmv),
            jnp.stack(sk), jnp.stack(sv), jnp.stack(ss))
```

```cpp
#include <hip/hip_runtime.h>
#include <hip/hip_cooperative_groups.h>
#include <cstdio>
namespace cg = cooperative_groups;

#define LAS __attribute__((address_space(3)))
typedef unsigned short bf16_t;
typedef short bf16x8 __attribute__((ext_vector_type(8)));
typedef short bf16x4 __attribute__((ext_vector_type(4)));
typedef float f32x4 __attribute__((ext_vector_type(4)));
typedef float f32x2 __attribute__((ext_vector_type(2)));
typedef unsigned u32x4 __attribute__((ext_vector_type(4)));
typedef unsigned u32x2 __attribute__((ext_vector_type(2)));

#ifndef ONE_LAUNCH
#define ONE_LAUNCH 1
#endif

constexpr int NTHR = 512;
constexpr int TP = 32768, TS = 1024, TT = TP + TS;
constexpr int NPOS = 4104;
constexpr float EPS = 1e-6f;
constexpr float LOG2E = 1.4426950408889634f;
constexpr int LDS_BYTES = 147456;

constexpr size_t O_SWAKP = (size_t)TT * 1024;
constexpr size_t O_SWAVP = O_SWAKP + 131072;
constexpr size_t O_RETP = O_SWAVP + 131072;
constexpr size_t O_MEMKP = O_RETP + 262144;
constexpr size_t O_MEMVP = O_MEMKP + 1048576;
constexpr size_t O_SWAKS = O_MEMVP + 1048576;
constexpr size_t O_SWAVS = O_SWAKS + 2097152;
constexpr size_t O_RETS = O_SWAVS + 2097152;
constexpr size_t O_END = O_RETS + 4194304;

constexpr size_t WS_WIN = 0;
constexpr size_t WS_WOUT = WS_WIN + (size_t)2816 * 1024 * 2;
constexpr size_t WS_WMQ = WS_WOUT + (size_t)1024 * 1024 * 2;
constexpr size_t WS_WMKV = WS_WMQ + (size_t)512 * 1024 * 2;
constexpr size_t WS_WMO = WS_WMKV + (size_t)1024 * 1024 * 2;
constexpr size_t WS_WGU = WS_WMO + (size_t)1024 * 512 * 2;
constexpr size_t WS_WDN = WS_WGU + (size_t)5632 * 1024 * 2;
constexpr size_t WS_XB = WS_WDN + (size_t)1024 * 2816 * 2;
constexpr size_t WS_MEMB = WS_XB + (size_t)TT * 1024 * 2;
constexpr size_t WS_RSTD0 = WS_MEMB + (size_t)2048 * 1024 * 2;
constexpr size_t WS_RSTDM = WS_RSTD0 + (size_t)TT * 4;
constexpr size_t WS_ROPE = WS_RSTDM + 2048 * 4;
constexpr size_t ROPE_T = (size_t)NPOS * 32 * 4;
constexpr size_t WS_QA = WS_ROPE + 4 * ROPE_T;
constexpr size_t WS_KA = WS_QA + (size_t)TT * 512 * 2;
constexpr size_t WS_VA = WS_KA + (size_t)TT * 128 * 2;
constexpr size_t WS_QR = WS_VA + (size_t)TT * 128 * 2;
constexpr size_t WS_KR = WS_QR + (size_t)TT * 512 * 2;
constexpr size_t WS_VR = WS_KR + (size_t)TT * 512 * 2;
constexpr size_t WS_GS = WS_VR + (size_t)TT * 512 * 2;
constexpr size_t WS_HID = WS_QA;
constexpr size_t WS_MIX = WS_GS + (size_t)TT * 512 * 2;
constexpr size_t WS_OM = WS_MIX + (size_t)TT * 512 * 2;
constexpr size_t WS_KVLOC = WS_MIX + (size_t)TT * 1024 * 2;
constexpr size_t WS_ST = WS_KVLOC + (size_t)2048 * 4096 * 4;
constexpr size_t WS_SSQ1 = WS_ST + (size_t)2048 * 4096 * 2;
constexpr size_t WS_SSQ2 = WS_SSQ1 + (size_t)TT * 16 * 4;
constexpr size_t WS_SSQM = WS_SSQ2 + (size_t)TT * 16 * 4;
constexpr size_t WS_MKB = WS_SSQM + (size_t)TT * 8 * 4;
constexpr size_t WS_MVB = WS_MKB + (size_t)2048 * 512 * 2;
constexpr size_t WS_END = WS_MVB + (size_t)2048 * 512 * 2;
constexpr size_t WS_QM = WS_END + (1u << 20);
constexpr size_t WS_TOTAL = WS_QM + (size_t)TT * 512 * 2;

struct Params { const float* in[24]; float* out; unsigned char* ws; int lo, hi; };

typedef __bf16 bf16n2 __attribute__((ext_vector_type(2)));
__device__ __forceinline__ unsigned pk2(float a, float b) { const f32x2 v = {a, b}; union { bf16n2 h; unsigned u; } c; c.h = __builtin_convertvector(v, bf16n2); return c.u; }
__device__ __forceinline__ float bf2f(unsigned short h) { return __uint_as_float(((unsigned)h) << 16); }
__device__ __forceinline__ float bflo(unsigned w) { return __uint_as_float(w << 16); }
__device__ __forceinline__ float bfhi(unsigned w) { return __uint_as_float(w & 0xffff0000u); }
__device__ __forceinline__ u32x4 pack8(f32x4 a, f32x4 b) { u32x4 w; w.x = pk2(a[0], a[1]); w.y = pk2(a[2], a[3]); w.z = pk2(b[0], b[1]); w.w = pk2(b[2], b[3]); return w; }
__device__ __forceinline__ bf16x8 as_bf16x8(u32x4 w) { union { u32x4 u; bf16x8 b; } c; c.u = w; return c.b; }
__device__ __forceinline__ float dot4(f32x4 a) { return (a[0] * a[0] + a[1] * a[1]) + (a[2] * a[2] + a[3] * a[3]); }
__device__ __forceinline__ float ex2(float x) { return __builtin_amdgcn_exp2f(x); }
__device__ __forceinline__ float silu(float x) { return x * __builtin_amdgcn_rcpf(1.0f + ex2(-x * LOG2E)); }
__device__ __forceinline__ bf16x4 trread(LAS const unsigned char* p) { return __builtin_amdgcn_ds_read_tr16_b64_v4i16((LAS bf16x4*)p); }
__device__ __forceinline__ bf16x8 cat4(bf16x4 a, bf16x4 b) { return __builtin_shufflevector(a, b, 0, 1, 2, 3, 4, 5, 6, 7); }
__device__ __forceinline__ int posidx(int row) { return row < TP ? (row & 4095) : 4096 + ((row - TP) & 7); }
__device__ __forceinline__ float rowpos(int row) { return (float)(row < TP ? (row & 4095) : 16384 + ((row - TP) & 7)); }

namespace pg8 {
constexpr int BM = 256, BK = 64, HALF = 128, HTB = HALF * BK * 2, STAGE_BYTES = 8 * HTB, NXCD = 8, WGM = 8;
__device__ __forceinline__ int lds_byte(int r, int c) { const int st = (r >> 4) * 2 + (c >> 5), rr = r & 15, cc = c & 31, ob = rr * 64 + cc * 2; return st * 1024 + (ob ^ (((ob >> 9) & 1) << 5)); }
__device__ __forceinline__ void stage_rc(int b, int& R, int& C) { const int st = b / 1024, sb = b % 1024, swz = sb ^ (((sb >> 9) & 1) << 5); R = (st >> 1) * 16 + swz / 64; C = (st & 1) * 32 + (swz % 64) / 2; }
struct Unit { const char* A; const char* B; int pm, pn, kind; };

struct Sched {
    int nM, nN, nwg, G, c; const char* A; const char* B; size_t tstep;
    int xn, xnM; const char* xA; const char* xB;
    __device__ void init(const void* A_, const void* B_, int M, int N, int K, int G_, int c_) { nM = M / BM; nN = N / BM; nwg = nM * nN; G = G_; c = c_; A = (const char*)A_; B = (const char*)B_; tstep = (size_t)BM * K * 2; xn = 0; xnM = 1; xA = nullptr; xB = nullptr; }
    __device__ void extra(const void* A_, const void* B_, int M, int N) { xnM = M / BM; xn = xnM * (N / BM); xA = (const char*)A_; xB = (const char*)B_; }
    __device__ bool next(int i, Unit& u) const {
        const long L = (long)i * G + c;
        if (L < nwg) {
            int wgid = (int)L; { const int q = nwg / NXCD, r = nwg % NXCD, xcd = wgid % NXCD, off = wgid / NXCD; wgid = (xcd < r ? xcd * (q + 1) : r * (q + 1) + (xcd - r) * q) + off; }
            const int nig = WGM * nN, gid = wgid / nig, fm = gid * WGM, gsz = (nM - fm) < WGM ? (nM - fm) : WGM;
            u.pm = fm + ((wgid % nig) % gsz); u.pn = (wgid % nig) / gsz; u.kind = 0;
            u.A = A + (size_t)u.pm * tstep; u.B = B + (size_t)u.pn * tstep; return true;
        }
        const int X = (int)(L - nwg);
        if (X < xn) { u.pm = X % xnM; u.pn = X / xnM; u.kind = 1; u.A = xA + (size_t)u.pm * tstep; u.B = xB + (size_t)u.pn * tstep; return true; }
        return false;
    }
};

template <class Epi, class SchedT = Sched>
__device__ __forceinline__ void gemm_phase(LAS unsigned char* lds, const int K, const SchedT& S, const Epi& E) {
    const int tid = threadIdx.x, wid = __builtin_amdgcn_readfirstlane(tid >> 6), lane = tid & 63, wr = wid >> 2, wc = wid & 3, fr = lane & 15, fq = lane >> 4;
    const int nt = K / BK;
    unsigned voffA[2];
#pragma unroll
    for (int i = 0; i < 2; ++i) { int R, C; stage_rc(tid * 16 + i * 8192, R, C); voffA[i] = (unsigned)(R * K + C) * 2u; }
    const size_t kstep = (size_t)(BK * 2);
    const size_t hstep = (size_t)HALF * K * 2;
    const unsigned ldsw = (unsigned)wid * 1024u;
    const int aoff = lds_byte(wr * 64 + fr, fq * 8), boff = lds_byte(wc * 32 + fr, fq * 8);
#define PG8_SA(b, h) (((b) * 2 + (h)) * HTB)
#define PG8_SB(b, h) ((4 + (b) * 2 + (h)) * HTB)
#define PG8_STAGE(bufoff, gbase) do { _Pragma("unroll") for (int _i = 0; _i < 2; ++_i) \
        __builtin_amdgcn_global_load_lds((const unsigned*)((const char*)(gbase) + voffA[_i]), (LAS unsigned*)(lds + (bufoff) + ldsw + _i * 8192), 16, 0, 0); } while (0)
#define PG8_LDA(dst, b, h) do { _Pragma("unroll") for (int m = 0; m < 4; ++m) _Pragma("unroll") for (int k = 0; k < 2; ++k) dst[m][k] = *(const LAS bf16x8*)(lds + PG8_SA(b, h) + aoff + m * 2048 + k * 1024); } while (0)
#define PG8_LDB(dst, b, h) do { _Pragma("unroll") for (int n = 0; n < 2; ++n) _Pragma("unroll") for (int k = 0; k < 2; ++k) dst[n][k] = *(const LAS bf16x8*)(lds + PG8_SB(b, h) + boff + n * 2048 + k * 1024); } while (0)
#define PG8_MMA(ai, bj, At, Bt) do { __builtin_amdgcn_s_setprio(1); _Pragma("unroll") for (int m = 0; m < 4; ++m) _Pragma("unroll") for (int n = 0; n < 2; ++n) _Pragma("unroll") for (int k = 0; k < 2; ++k) \
        acc[ai][bj][m][n] = __builtin_amdgcn_mfma_f32_16x16x32_bf16(Bt[n][k], At[m][k], acc[ai][bj][m][n], 0, 0, 0); __builtin_amdgcn_s_setprio(0); } while (0)
#define PG8_WAIT_V(n) asm volatile("s_waitcnt vmcnt(" #n ")" ::: "memory")
#define PG8_WAIT_L(n) asm volatile("s_waitcnt lgkmcnt(" #n ")" ::: "memory")
#define PG8_BAR __builtin_amdgcn_s_barrier()
#define PG8_SCHED __builtin_amdgcn_sched_barrier(0)
    Unit cur, nxt; int ui = 0;
    if (!S.next(0, cur)) return;
    f32x4 acc[2][2][4][2];
#pragma unroll
    for (int a = 0; a < 2; ++a)
#pragma unroll
        for (int b = 0; b < 2; ++b)
#pragma unroll
            for (int m = 0; m < 4; ++m)
#pragma unroll
                for (int n = 0; n < 2; ++n) acc[a][b][m][n] = (f32x4){0.f, 0.f, 0.f, 0.f};
    bf16x8 At[4][2], B0[2][2], B1[2][2];
    const char* cA = cur.A; const char* cB = cur.B;
    PG8_STAGE(PG8_SB(0, 0), cB); PG8_STAGE(PG8_SA(0, 0), cA); PG8_STAGE(PG8_SB(0, 1), cB + hstep); PG8_STAGE(PG8_SA(0, 1), cA + hstep);
    if (wr == 1) PG8_BAR;
    PG8_WAIT_V(4); PG8_BAR;
    PG8_STAGE(PG8_SB(1, 0), cB + kstep); PG8_STAGE(PG8_SA(1, 0), cA + kstep); PG8_STAGE(PG8_SB(1, 1), cB + hstep + kstep);
    PG8_WAIT_V(6); PG8_BAR;
    for (;;) {
        const bool has_next = S.next(ui + 1, nxt);
        const char* nA = has_next ? nxt.A : cA; const char* nB = has_next ? nxt.B : cB;
        for (int t = 0; t < nt; t += 2) {
            const bool last = (t == nt - 2);
            const char* a1 = cA + (size_t)(t + 1) * kstep;
            const char* a2 = last ? nA : cA + (size_t)(t + 2) * kstep; const char* b2 = last ? nB : cB + (size_t)(t + 2) * kstep;
            const char* a3 = a2 + kstep; const char* b3 = b2 + kstep;
            PG8_LDB(B0, 0, 0); PG8_SCHED; PG8_LDA(At, 0, 0); PG8_STAGE(PG8_SA(1, 1), a1 + hstep);
            PG8_WAIT_L(8); PG8_BAR; PG8_WAIT_L(0); PG8_MMA(0, 0, At, B0); PG8_BAR; PG8_SCHED;
            PG8_LDB(B1, 0, 1); PG8_STAGE(PG8_SB(0, 0), b2);
            PG8_BAR; PG8_WAIT_L(0); PG8_MMA(0, 1, At, B1); PG8_BAR;
            PG8_LDA(At, 0, 1); PG8_STAGE(PG8_SA(0, 0), a2);
            PG8_BAR; PG8_WAIT_L(0); PG8_MMA(1, 0, At, B0); PG8_BAR; PG8_SCHED;
            PG8_STAGE(PG8_SB(0, 1), b2 + hstep);
            PG8_WAIT_V(6); PG8_BAR; PG8_MMA(1, 1, At, B1); PG8_BAR;
            PG8_LDB(B0, 1, 0); PG8_SCHED; PG8_LDA(At, 1, 0); PG8_STAGE(PG8_SA(0, 1), a2 + hstep);
            PG8_WAIT_L(8); PG8_BAR; PG8_WAIT_L(0); PG8_MMA(0, 0, At, B0); PG8_BAR; PG8_SCHED;
            PG8_LDB(B1, 1, 1); PG8_STAGE(PG8_SB(1, 0), b3);
            PG8_BAR; PG8_WAIT_L(0); PG8_MMA(0, 1, At, B1); PG8_BAR;
            PG8_LDA(At, 1, 1); PG8_STAGE(PG8_SA(1, 0), a3);
            PG8_BAR; PG8_WAIT_L(0); PG8_MMA(1, 0, At, B0); PG8_BAR; PG8_SCHED;
            PG8_STAGE(PG8_SB(1, 1), b3 + hstep);
            PG8_WAIT_V(6); PG8_BAR; PG8_MMA(1, 1, At, B1); PG8_BAR;
        }
        E(acc, cur, wr, wc, fr, fq);
        if (!has_next) break;
#pragma unroll
        for (int a = 0; a < 2; ++a)
#pragma unroll
            for (int b = 0; b < 2; ++b)
#pragma unroll
                for (int m = 0; m < 4; ++m)
#pragma unroll
                    for (int n = 0; n < 2; ++n) acc[a][b][m][n] = (f32x4){0.f, 0.f, 0.f, 0.f};
        cur = nxt; cA = nA; cB = nB; ++ui;
    }
    PG8_WAIT_V(0);
    if (wr == 0) PG8_BAR;
    PG8_BAR;
#undef PG8_SA
#undef PG8_SB
#undef PG8_STAGE
#undef PG8_LDA
#undef PG8_LDB
#undef PG8_MMA
#undef PG8_WAIT_V
#undef PG8_WAIT_L
#undef PG8_BAR
#undef PG8_SCHED
}
}
using pg8::Unit;


struct EpiA {
    unsigned char* ws; const float* gq; const float* gk; float* out;
    __device__ __forceinline__ void operator()(const f32x4 (&acc)[2][2][4][2], const Unit& u, int wr, int wc, int fr, int fq) const {
        const int pn = u.pn;
        const float* rstd0 = (const float*)(ws + WS_RSTD0); const float* rstdm = (const float*)(ws + WS_RSTDM);
        const float* cosA = (const float*)(ws + WS_ROPE); const float* sinA = (const float*)(ws + WS_ROPE + ROPE_T); const float* cosR = (const float*)(ws + WS_ROPE + 2 * ROPE_T); const float* sinR = (const float*)(ws + WS_ROPE + 3 * ROPE_T);
        float rsv[8];
#pragma unroll
        for (int it = 0; it < 8; ++it) { const int r_ = u.pm * 256 + (it >> 2) * 128 + wr * 64 + (it & 3) * 16 + fr; rsv[it] = (u.kind == 0) ? rstd0[r_] : rstdm[r_]; }
        bf16_t* qa = (bf16_t*)(ws + WS_QA); bf16_t* ka = (bf16_t*)(ws + WS_KA); bf16_t* va = (bf16_t*)(ws + WS_VA); bf16_t* qr = (bf16_t*)(ws + WS_QR); bf16_t* kr = (bf16_t*)(ws + WS_KR); bf16_t* vr = (bf16_t*)(ws + WS_VR); bf16_t* gs = (bf16_t*)(ws + WS_GS); bf16_t* mvb = (bf16_t*)(ws + WS_MVB);
        if (u.kind == 0) {
            if (pn < 2 || (pn == 2 && wc < 2)) {
                const bool isq = pn < 2;
                const float* gp = isq ? gq : gk;
                const float osc = isq ? 0.125f * LOG2E : 1.0f;
#pragma unroll
                for (int ai = 0; ai < 2; ++ai)
#pragma unroll
                    for (int m = 0; m < 4; ++m) {
                        const int row = u.pm * 256 + ai * 128 + wr * 64 + m * 16 + fr;
                        const float rs = rsv[ai * 4 + m];
                        f32x4 v00 = acc[ai][0][m][0] * rs, v01 = acc[ai][0][m][1] * rs, v10 = acc[ai][1][m][0] * rs, v11 = acc[ai][1][m][1] * rs;
                        float ss = (dot4(v00) + dot4(v01)) + (dot4(v10) + dot4(v11));
                        ss += __shfl_xor(ss, 16); ss += __shfl_xor(ss, 32);
                        const float rn = __builtin_amdgcn_rsqf(ss * (1.0f / 64.0f) + EPS);
                        v00 = v00 * rn * *(const f32x4*)(gp + 8 * fq); v01 = v01 * rn * *(const f32x4*)(gp + 8 * fq + 4); v10 = v10 * rn * *(const f32x4*)(gp + 32 + 8 * fq); v11 = v11 * rn * *(const f32x4*)(gp + 36 + 8 * fq);
                        const float posf = rowpos(row);
                        int fqv = fq; asm volatile("" : "+v"(fqv));
                        f32x4 c0, c1, s0, s1;
#pragma unroll
                        for (int j = 0; j < 4; ++j) { const float a0 = __builtin_amdgcn_fractf(posf * (ex2((float)(8 * fqv + j) * (-13.287712379549449f / 32.0f)) * 0.15915494309189535f)), a1 = __builtin_amdgcn_fractf(posf * (ex2((float)(8 * fqv + 4 + j) * (-13.287712379549449f / 32.0f)) * 0.15915494309189535f));
                            c0[j] = __builtin_amdgcn_cosf(a0); s0[j] = __builtin_amdgcn_sinf(a0); c1[j] = __builtin_amdgcn_cosf(a1); s1[j] = __builtin_amdgcn_sinf(a1); }
                        const f32x4 o00 = (v00 * c0 - v10 * s0) * osc, o10 = (v10 * c0 + v00 * s0) * osc, o01 = (v01 * c1 - v11 * s1) * osc, o11 = (v11 * c1 + v01 * s1) * osc;
                        if (isq) {
                            bf16_t* d = qa + (size_t)row * 512 + (pn * 4 + wc) * 64 + 8 * fq;
                            *(u32x4*)d = pack8(o00, o01); *(u32x4*)(d + 32) = pack8(o10, o11);
                        } else {
                            bf16_t* d = ka + (size_t)row * 128 + wc * 64 + 8 * fq;
                            *(u32x4*)d = pack8(o00, o01); *(u32x4*)(d + 32) = pack8(o10, o11);
                            float* fo = nullptr;
                            if (u.pm >= 128) { const int r = row - TP; fo = out + O_SWAKS + ((size_t)((r >> 3) * 128 + 120 + (r & 7)) * 2 + wc) * 64; }
                            else if ((u.pm & 15) == 15 && ai == 1) { fo = out + O_SWAKP + ((size_t)((row >> 12) * 128 + ((row & 4095) - 3968)) * 2 + wc) * 64; }
                            if (fo) { fo += 8 * fq; *(f32x4*)fo = o00; *(f32x4*)(fo + 4) = o01; *(f32x4*)(fo + 32) = o10; *(f32x4*)(fo + 36) = o11; }
                        }
                    }
            } else if (pn == 2) {
                const int kvh = wc - 2;
#pragma unroll
                for (int ai = 0; ai < 2; ++ai)
#pragma unroll
                    for (int m = 0; m < 4; ++m) {
                        const int row = u.pm * 256 + ai * 128 + wr * 64 + m * 16 + fr;
                        const float rs = rsv[ai * 4 + m];
                        const f32x4 v00 = acc[ai][0][m][0] * rs, v01 = acc[ai][0][m][1] * rs, v10 = acc[ai][1][m][0] * rs, v11 = acc[ai][1][m][1] * rs;
                        bf16_t* d = va + (size_t)row * 128 + kvh * 64 + 8 * fq;
                        *(u32x4*)d = pack8(v00, v01); *(u32x4*)(d + 32) = pack8(v10, v11);
                        float* fo = nullptr;
                        if (u.pm >= 128) { const int r = row - TP; fo = out + O_SWAVS + ((size_t)((r >> 3) * 128 + 120 + (r & 7)) * 2 + kvh) * 64; }
                        else if ((u.pm & 15) == 15 && ai == 1) { fo = out + O_SWAVP + ((size_t)((row >> 12) * 128 + ((row & 4095) - 3968)) * 2 + kvh) * 64; }
                        if (fo) { fo += 8 * fq; *(f32x4*)fo = v00; *(f32x4*)(fo + 4) = v01; *(f32x4*)(fo + 32) = v10; *(f32x4*)(fo + 36) = v11; }
                    }
            } else if (pn <= 6) {
                const bool isq = pn <= 4;
                bf16_t* base = isq ? qr : kr;
                const int head = ((pn - 3) & 1) * 4 + wc;
                const float osc = isq ? 1.0f : 0.125f;
#pragma unroll
                for (int ai = 0; ai < 2; ++ai)
#pragma unroll
                    for (int m = 0; m < 4; ++m) {
                        const int row = u.pm * 256 + ai * 128 + wr * 64 + m * 16 + fr;
                        const float rs = rsv[ai * 4 + m] * osc;
                        const float posf = rowpos(row);
                        int fqv = fq; asm volatile("" : "+v"(fqv));
                        f32x4 o[2][2];
#pragma unroll
                        for (int bj = 0; bj < 2; ++bj)
#pragma unroll
                            for (int n = 0; n < 2; ++n) {
                                const f32x4 v = acc[ai][bj][m][n] * rs;
                                const float a0 = __builtin_amdgcn_fractf(posf * (ex2((float)(16 * bj + 4 * fqv + 2 * n) * (-13.287712379549449f / 31.0f)) * 0.15915494309189535f)), a1 = __builtin_amdgcn_fractf(posf * (ex2((float)(16 * bj + 4 * fqv + 2 * n + 1) * (-13.287712379549449f / 31.0f)) * 0.15915494309189535f));
                                const f32x2 c = {__builtin_amdgcn_cosf(a0), __builtin_amdgcn_cosf(a1)}, s = {__builtin_amdgcn_sinf(a0), __builtin_amdgcn_sinf(a1)};
                                o[bj][n] = (f32x4){v[0] * c[0] - v[1] * s[0], v[1] * c[0] + v[0] * s[0], v[2] * c[1] - v[3] * s[1], v[3] * c[1] + v[2] * s[1]};
                            }
                        bf16_t* d = base + (size_t)row * 512 + head * 64 + 8 * fq;
                        *(u32x4*)d = pack8(o[0][0], o[0][1]); *(u32x4*)(d + 32) = pack8(o[1][0], o[1][1]);
                    }
            } else {
                const bool isg = pn >= 9;
                bf16_t* base = isg ? gs : vr;
                const int head = ((pn - 7) & 1) * 4 + wc;
#pragma unroll
                for (int ai = 0; ai < 2; ++ai)
#pragma unroll
                    for (int m = 0; m < 4; ++m) {
                        const int row = u.pm * 256 + ai * 128 + wr * 64 + m * 16 + fr;
                        const float rs = rsv[ai * 4 + m];
                        f32x4 o[2][2];
#pragma unroll
                        for (int bj = 0; bj < 2; ++bj)
#pragma unroll
                            for (int n = 0; n < 2; ++n) {
                                f32x4 v = acc[ai][bj][m][n] * rs;
                                if (isg) { v[0] = silu(v[0]); v[1] = silu(v[1]); v[2] = silu(v[2]); v[3] = silu(v[3]); }
                                o[bj][n] = v;
                            }
                        bf16_t* d = base + (size_t)row * 512 + head * 64 + 8 * fq;
                        *(u32x4*)d = pack8(o[0][0], o[0][1]); *(u32x4*)(d + 32) = pack8(o[1][0], o[1][1]);
                    }
            }
        } else {
            const bool isk = pn < 2;
            const int cb = (pn & 1) * 256 + wc * 64 + 8 * fq;
#pragma unroll
            for (int ai = 0; ai < 2; ++ai)
#pragma unroll
                for (int m = 0; m < 4; ++m) {
                    const int row = u.pm * 256 + ai * 128 + wr * 64 + m * 16 + fr;
                    const float rs = rsv[ai * 4 + m];
                    const f32x4 v00 = acc[ai][0][m][0] * rs, v01 = acc[ai][0][m][1] * rs, v10 = acc[ai][1][m][0] * rs, v11 = acc[ai][1][m][1] * rs;
                    float* fo = out + (isk ? O_MEMKP : O_MEMVP) + (size_t)row * 512 + cb;
                    *(f32x4*)fo = v00; *(f32x4*)(fo + 4) = v01; *(f32x4*)(fo + 32) = v10; *(f32x4*)(fo + 36) = v11;
                    if (!isk) { bf16_t* d = mvb + (size_t)row * 512 + cb; *(u32x4*)d = pack8(v00, v01); *(u32x4*)(d + 32) = pack8(v10, v11); }
                }
        }
    }
};

template <int MODE>
struct EpiRes {
    const float* xp; const float* xs; float* out; bf16_t* xb; float* ssq;
    __device__ __forceinline__ void operator()(const f32x4 (&acc)[2][2][4][2], const Unit& u, int wr, int wc, int fr, int fq) const {
        const int cb = u.pn * 256 + wc * 64 + 8 * fq;
        const int row0 = u.pm * 256 + wr * 64 + fr;
        if (MODE == 0) {
            const float* base = (u.pm < 128 ? xp + (size_t)row0 * 1024 : xs + (size_t)(row0 - TP) * 1024) + cb;
            f32x4 nb[4];
            nb[0] = *(const f32x4*)base; nb[1] = *(const f32x4*)(base + 4); nb[2] = *(const f32x4*)(base + 32); nb[3] = *(const f32x4*)(base + 36);
#pragma unroll
            for (int it = 0; it < 8; ++it) {
                const int ai = it >> 2, m = it & 3;
                const int row = row0 + ai * 128 + m * 16;
                const f32x4 r00 = nb[0] + acc[ai][0][m][0], r01 = nb[1] + acc[ai][0][m][1], r10 = nb[2] + acc[ai][1][m][0], r11 = nb[3] + acc[ai][1][m][1];
                if (it < 7) { const float* bp = base + (size_t)(((it + 1) >> 2) * 128 + ((it + 1) & 3) * 16) * 1024;
                    nb[0] = *(const f32x4*)bp; nb[1] = *(const f32x4*)(bp + 4); nb[2] = *(const f32x4*)(bp + 32); nb[3] = *(const f32x4*)(bp + 36); }
                bf16_t* d = xb + (size_t)row * 1024 + cb;
                *(u32x4*)d = pack8(r00, r01); *(u32x4*)(d + 32) = pack8(r10, r11);
                float ss = (dot4(r00) + dot4(r01)) + (dot4(r10) + dot4(r11));
                ss += __shfl_xor(ss, 16); ss += __shfl_xor(ss, 32);
                if (fq == 0) ssq[(size_t)(u.pn * 4 + wc) * TT + row] = ss;
            }
        } else {
            u32x4 b[8][2];
#pragma unroll
            for (int it = 0; it < 4; ++it) { const bf16_t* bp = xb + (size_t)(row0 + (it >> 2) * 128 + (it & 3) * 16) * 1024 + cb;
                if (MODE == 2) { b[it][0] = __builtin_nontemporal_load((const u32x4*)bp); b[it][1] = __builtin_nontemporal_load((const u32x4*)(bp + 32)); } else { b[it][0] = *(const u32x4*)bp; b[it][1] = *(const u32x4*)(bp + 32); } }
#pragma unroll
            for (int it = 0; it < 8; ++it) {
                const int ai = it >> 2, m = it & 3;
                const int row = row0 + ai * 128 + m * 16;
                const u32x4 w0 = b[it][0], w1 = b[it][1];
                if (it < 4) { const bf16_t* bp = xb + (size_t)(row0 + 128 + it * 16) * 1024 + cb;
                    if (MODE == 2) { b[it + 4][0] = __builtin_nontemporal_load((const u32x4*)bp); b[it + 4][1] = __builtin_nontemporal_load((const u32x4*)(bp + 32)); } else { b[it + 4][0] = *(const u32x4*)bp; b[it + 4][1] = *(const u32x4*)(bp + 32); } }
                const f32x4 r00 = (f32x4){bflo(w0.x), bfhi(w0.x), bflo(w0.y), bfhi(w0.y)} + acc[ai][0][m][0], r01 = (f32x4){bflo(w0.z), bfhi(w0.z), bflo(w0.w), bfhi(w0.w)} + acc[ai][0][m][1];
                const f32x4 r10 = (f32x4){bflo(w1.x), bfhi(w1.x), bflo(w1.y), bfhi(w1.y)} + acc[ai][1][m][0], r11 = (f32x4){bflo(w1.z), bfhi(w1.z), bflo(w1.w), bfhi(w1.w)} + acc[ai][1][m][1];
                if (MODE == 1) {
                    bf16_t* d = xb + (size_t)row * 1024 + cb;
                    *(u32x4*)d = pack8(r00, r01); *(u32x4*)(d + 32) = pack8(r10, r11);
                    float ss = (dot4(r00) + dot4(r01)) + (dot4(r10) + dot4(r11));
                    ss += __shfl_xor(ss, 16); ss += __shfl_xor(ss, 32);
                    if (fq == 0) ssq[(size_t)(u.pn * 4 + wc) * TT + row] = ss;
                } else {
                    float* op = out + (size_t)row * 1024 + cb;
                    __builtin_nontemporal_store(r00, (f32x4*)op); __builtin_nontemporal_store(r01, (f32x4*)(op + 4)); __builtin_nontemporal_store(r10, (f32x4*)(op + 32)); __builtin_nontemporal_store(r11, (f32x4*)(op + 36));
                }
            }
        }
    }
};

__device__ __forceinline__ float row_rstd16(const float* ssq, int row, int fq) {
    const float* pp = ssq + (size_t)(4 * fq) * TT + row;
    float s = (pp[0] + pp[TT]) + (pp[2 * (size_t)TT] + pp[3 * (size_t)TT]);
    s += __shfl_xor(s, 16); s += __shfl_xor(s, 32);
    return __builtin_amdgcn_rsqf(s * (1.0f / 1024.0f) + EPS);
}

struct EpiMq {
    const float* ssq1; bf16_t* qm; float* ssqm;
    __device__ __forceinline__ void operator()(const f32x4 (&acc)[2][2][4][2], const Unit& u, int wr, int wc, int fr, int fq) const {
        const int cb = u.pn * 256 + wc * 64 + 8 * fq;
        float rsv[8];
#pragma unroll
        for (int it = 0; it < 8; ++it) rsv[it] = row_rstd16(ssq1, u.pm * 256 + (it >> 2) * 128 + wr * 64 + (it & 3) * 16 + fr, fq);
#pragma unroll
        for (int ai = 0; ai < 2; ++ai)
#pragma unroll
            for (int m = 0; m < 4; ++m) {
                const int row = u.pm * 256 + ai * 128 + wr * 64 + m * 16 + fr;
                const float rs = rsv[ai * 4 + m];
                const f32x4 v00 = acc[ai][0][m][0] * rs, v01 = acc[ai][0][m][1] * rs, v10 = acc[ai][1][m][0] * rs, v11 = acc[ai][1][m][1] * rs;
                bf16_t* d = qm + (size_t)row * 512 + cb;
                *(u32x4*)d = pack8(v00, v01); *(u32x4*)(d + 32) = pack8(v10, v11);
                float ss = (dot4(v00) + dot4(v01)) + (dot4(v10) + dot4(v11));
                ss += __shfl_xor(ss, 16); ss += __shfl_xor(ss, 32);
                if (fq == 0) ssqm[(size_t)(u.pn * 4 + wc) * TT + row] = ss;
            }
    }
};

struct EpiGu {
    const float* ssq2; bf16_t* hid; unsigned* ready;
    __device__ __forceinline__ void operator()(const f32x4 (&acc)[2][2][4][2], const Unit& u, int wr, int wc, int fr, int fq) const {
        const int cb = u.pn * 128 + wc * 32 + 8 * fq;
        float rsv[8];
#pragma unroll
        for (int it = 0; it < 8; ++it) rsv[it] = row_rstd16(ssq2, u.pm * 256 + (it >> 2) * 128 + wr * 64 + (it & 3) * 16 + fr, fq);
#pragma unroll
        for (int ai = 0; ai < 2; ++ai)
#pragma unroll
            for (int m = 0; m < 4; ++m) {
                const int row = u.pm * 256 + ai * 128 + wr * 64 + m * 16 + fr;
                const float rs = rsv[ai * 4 + m];
                f32x4 h[2];
#pragma unroll
                for (int n = 0; n < 2; ++n) {
                    const f32x4 g = acc[ai][0][m][n] * rs, uu = acc[ai][1][m][n] * rs;
                    h[n] = (f32x4){silu(g[0]) * uu[0], silu(g[1]) * uu[1], silu(g[2]) * uu[2], silu(g[3]) * uu[3]};
                }
                *(u32x4*)(hid + (size_t)row * 2816 + cb) = pack8(h[0], h[1]);
            }
        if (u.pm >= 128) {
            asm volatile("s_waitcnt vmcnt(0)" ::: "memory");
            __builtin_amdgcn_fence(__ATOMIC_RELEASE, "agent");
            asm volatile("s_waitcnt vmcnt(0)" ::: "memory");
            if ((threadIdx.x & 63) == 0) (void)__hip_atomic_fetch_add(ready, 1u, __ATOMIC_RELAXED, __HIP_MEMORY_SCOPE_AGENT);
        }
    }
};
struct SchedOne {
    const char* A; const char* B; int pm, pn; bool on;
    __device__ bool next(int i, Unit& u) const { if (i > 0 || !on) return false; u.pm = pm; u.pn = pn; u.kind = 0; u.A = A; u.B = B; return true; }
};
struct SchedGu {
    pg8::Sched P; int G, c; const char* A; const char* B;
    __device__ bool next(int i, Unit& u) const {
        long L;
        if (G == 256) {
            if (c < 240) { L = (long)i * 240 + c; if (L >= 2760) return false; }
            else { if (i >= 9) return false; L = 2760 + (long)(c - 240) * 9 + i; }
        } else L = (long)i * G + c;
        if (L < 88) { u.pm = 128 + (int)(L & 3); u.pn = (int)(L >> 2); u.kind = 0; u.A = A + (size_t)u.pm * 256 * 1024 * 2; u.B = B + (size_t)u.pn * 256 * 1024 * 2; return true; }
        const long Lp = L - 88;
        if (Lp >= P.nwg) return false;
        pg8::Sched Q = P; Q.G = 1; Q.c = 0;
        return Q.next((int)Lp, u);
    }
};
struct SchedDnTail {
    const char* A; const char* B; int u0;
    __device__ bool next(int i, Unit& u) const {
        if (i > 0 || u0 < 0 || u0 >= 16) return false;
        u.pm = 128 + (u0 & 3); u.pn = u0 >> 2; u.kind = 0;
        u.A = A + (size_t)u.pm * 256 * 2816 * 2; u.B = B + (size_t)u.pn * 256 * 2816 * 2; return true;
    }
};

__device__ __forceinline__ int srccol(int p, int mode) {
    const int tile = p >> 8, q = p & 255, bj = q >> 7, wc = (q >> 5) & 3, n = (q >> 4) & 1, fq = (q >> 2) & 3, j = q & 3;
    if (mode == 0) return tile * 256 + 64 * wc + 32 * bj + 8 * fq + 4 * n + j;
    return bj * 2816 + 128 * tile + 32 * wc + 8 * fq + 4 * n + j;
}
__device__ __forceinline__ void conv_w(const float* __restrict__ W, bf16_t* __restrict__ Wt, const float* __restrict__ gain, int K, int N, int mode, int gtid, int gsz) {
    const int n4 = N >> 2, n48 = n4 >> 3, total = n4 * (K >> 3);
    for (int it = gtid; it < total; it += gsz) {
        const int rest = it >> 6, pg = (rest % n48) * 8 + ((it >> 3) & 7), kc = (rest / n48) * 8 + (it & 7);
        const int p0 = pg * 4, k0 = kc * 8; const int src = srccol(p0, mode);
        f32x4 v[8];
#pragma unroll
        for (int j = 0; j < 8; ++j) { v[j] = __builtin_nontemporal_load((const f32x4*)(W + (size_t)(k0 + j) * N + src)); if (gain) v[j] = v[j] * gain[k0 + j]; }
#pragma unroll
        for (int i = 0; i < 4; ++i) {
            u32x4 o; o.x = pk2(v[0][i], v[1][i]); o.y = pk2(v[2][i], v[3][i]); o.z = pk2(v[4][i], v[5][i]); o.w = pk2(v[6][i], v[7][i]);
            *(u32x4*)(Wt + (size_t)(p0 + i) * K + k0) = o;
        }
    }
}
__device__ __forceinline__ void phase0(const Params& P) {
    unsigned char* ws = P.ws;
    const int tid = threadIdx.x, lane = tid & 63, wave = tid >> 6;
    const int gtid = blockIdx.x * NTHR + tid, gsz = gridDim.x * NTHR;
    for (int row0 = (blockIdx.x * 8 + wave) * 8; row0 < TT + 2048; row0 += gridDim.x * 64) {
        const float* src[8]; bf16_t* dst[8]; float* rs[8];
#pragma unroll
        for (int r = 0; r < 8; ++r) {
            const int row = row0 + r;
            if (row < TP) { src[r] = P.in[0] + (size_t)row * 1024; dst[r] = (bf16_t*)(ws + WS_XB) + (size_t)row * 1024; rs[r] = (float*)(ws + WS_RSTD0) + row; }
            else if (row < TT) { src[r] = P.in[1] + (size_t)(row - TP) * 1024; dst[r] = (bf16_t*)(ws + WS_XB) + (size_t)row * 1024; rs[r] = (float*)(ws + WS_RSTD0) + row; }
            else { src[r] = P.in[2] + (size_t)(row - TT) * 1024; dst[r] = (bf16_t*)(ws + WS_MEMB) + (size_t)(row - TT) * 1024; rs[r] = (float*)(ws + WS_RSTDM) + (row - TT); }
        }
        f32x4 v[8][4]; float ss[8] = {0.f, 0.f, 0.f, 0.f, 0.f, 0.f, 0.f, 0.f};
#pragma unroll
        for (int r = 0; r < 8; ++r)
#pragma unroll
            for (int i = 0; i < 4; ++i) v[r][i] = __builtin_nontemporal_load((const f32x4*)(src[r] + 4 * (lane + 64 * i)));
#pragma unroll
        for (int r = 0; r < 8; ++r) {
#pragma unroll
            for (int i = 0; i < 4; ++i) ss[r] += dot4(v[r][i]);
#pragma unroll
            for (int o = 1; o < 64; o <<= 1) ss[r] += __shfl_xor(ss[r], o);
            if (lane == 0) *rs[r] = __builtin_amdgcn_rsqf(ss[r] * (1.0f / 1024.0f) + EPS);
#pragma unroll
            for (int i = 0; i < 4; ++i) { u32x2 w; w.x = pk2(v[r][i][0], v[r][i][1]); w.y = pk2(v[r][i][2], v[r][i][3]); *(u32x2*)(dst[r] + 4 * (lane + 64 * i)) = w; }
        }
    }
    conv_w(P.in[9], (bf16_t*)(ws + WS_WIN), P.in[8], 1024, 2816, 0, gtid, gsz);
    conv_w(P.in[13], (bf16_t*)(ws + WS_WOUT), nullptr, 1024, 1024, 0, gtid, gsz);
    conv_w(P.in[16], (bf16_t*)(ws + WS_WMQ), P.in[14], 1024, 512, 0, gtid, gsz);
    conv_w(P.in[17], (bf16_t*)(ws + WS_WMKV), P.in[15], 1024, 1024, 0, gtid, gsz);
    conv_w(P.in[20], (bf16_t*)(ws + WS_WMO), nullptr, 512, 1024, 0, gtid, gsz);
    conv_w(P.in[22], (bf16_t*)(ws + WS_WGU), P.in[21], 1024, 5632, 1, gtid, gsz);
    conv_w(P.in[23], (bf16_t*)(ws + WS_WDN), nullptr, 2816, 1024, 0, gtid, gsz);
}

constexpr int KS64 = 144;
constexpr int KS128 = 272;

__device__ __forceinline__ void swa_qblock(LAS const unsigned char* Kl, LAS const unsigned char* Vl, int kb_lo, const bf16_t* qptr, bf16_t* optr, bool do_store,
                                           int qi, int jmin, float sink2, int lane) {
    const int fr = lane & 15, fq = lane >> 4;
    bf16x8 qf[2]; qf[0] = *(const bf16x8*)(qptr + 8 * fq); qf[1] = *(const bf16x8*)(qptr + 32 + 8 * fq);
    f32x4 s[10];
    LAS const unsigned char* kbase = Kl + (kb_lo * 16 + fr) * KS64 + fq * 16;
#pragma unroll
    for (int i = 0; i < 10; ++i) {
        f32x4 a = {0.f, 0.f, 0.f, 0.f};
#pragma unroll
        for (int ks = 0; ks < 2; ++ks) { const bf16x8 kf = *(LAS const bf16x8*)(kbase + i * 16 * KS64 + ks * 64); a = __builtin_amdgcn_mfma_f32_16x16x32_bf16(kf, qf[ks], a, 0, 0, 0); }
        s[i] = a;
        if (i & 1) __builtin_amdgcn_sched_barrier(0);
    }
    float mx = sink2;
    const int jb = kb_lo * 16 + 4 * fq;
#pragma unroll
    for (int i = 0; i < 10; ++i)
#pragma unroll
        for (int e = 0; e < 4; ++e) { const int j = jb + 16 * i + e; const bool ok = (j > qi) && (j <= qi + 128) && (j >= jmin); const float v = ok ? s[i][e] : -1e30f; s[i][e] = v; mx = fmaxf(mx, v); }
    mx = fmaxf(mx, __shfl_xor(mx, 16)); mx = fmaxf(mx, __shfl_xor(mx, 32));
    float sum = 0.f;
#pragma unroll
    for (int i = 0; i < 10; ++i)
#pragma unroll
        for (int e = 0; e < 4; ++e) { const float p = ex2(s[i][e] - mx); s[i][e] = p; sum += p; }
    sum += __shfl_xor(sum, 16); sum += __shfl_xor(sum, 32);
    sum += ex2(sink2 - mx);
    const float inv = __builtin_amdgcn_rcpf(sum);
    f32x4 o[4];
#pragma unroll
    for (int d = 0; d < 4; ++d) o[d] = (f32x4){0.f, 0.f, 0.f, 0.f};
    LAS const unsigned char* vbase = Vl + (kb_lo * 16 + 4 * fq + (fr >> 2)) * KS64 + (fr & 3) * 8;
#pragma unroll
    for (int g = 0; g < 5; ++g) {
        const bf16x8 pf = as_bf16x8(pack8(s[2 * g] * inv, s[2 * g + 1] * inv));
#pragma unroll
        for (int db = 0; db < 4; ++db) {
            const bf16x4 v0 = trread(vbase + (2 * g) * 16 * KS64 + db * 32), v1 = trread(vbase + (2 * g + 1) * 16 * KS64 + db * 32);
            o[db] = __builtin_amdgcn_mfma_f32_16x16x32_bf16(cat4(v0, v1), pf, o[db], 0, 0, 0);
        }
        __builtin_amdgcn_sched_barrier(0);
    }
    if (do_store) {
#pragma unroll
        for (int db = 0; db < 4; ++db) { u32x2 w; w.x = pk2(o[db][0], o[db][1]); w.y = pk2(o[db][2], o[db][3]); *(u32x2*)(optr + 16 * db + 4 * fq) = w; }
    }
}

__device__ __forceinline__ void swa_qblock2(LAS const unsigned char* Kl, LAS const unsigned char* Vl, int kb_lo, const bf16_t* qptr, bf16_t* optr,
                                            int qi, int jmin, float sinkA, float sinkB, int lane) {
    const int fr = lane & 15, fq = lane >> 4;
    bf16x8 qf[2][2];
#pragma unroll
    for (int h2 = 0; h2 < 2; ++h2) { qf[h2][0] = __builtin_nontemporal_load((const bf16x8*)(qptr + 64 * h2 + 8 * fq)); qf[h2][1] = __builtin_nontemporal_load((const bf16x8*)(qptr + 64 * h2 + 32 + 8 * fq)); }
    f32x4 s[2][10];
    LAS const unsigned char* kbase = Kl + (kb_lo * 16 + fr) * KS64 + fq * 16;
#pragma unroll
    for (int i = 0; i < 10; ++i) {
        f32x4 a0 = {0.f, 0.f, 0.f, 0.f}, a1 = {0.f, 0.f, 0.f, 0.f};
#pragma unroll
        for (int ks = 0; ks < 2; ++ks) { const bf16x8 kf = *(LAS const bf16x8*)(kbase + i * 16 * KS64 + ks * 64);
            a0 = __builtin_amdgcn_mfma_f32_16x16x32_bf16(kf, qf[0][ks], a0, 0, 0, 0); a1 = __builtin_amdgcn_mfma_f32_16x16x32_bf16(kf, qf[1][ks], a1, 0, 0, 0); }
        s[0][i] = a0; s[1][i] = a1;
        if (i & 1) __builtin_amdgcn_sched_barrier(0);
    }
    const int jb = kb_lo * 16 + 4 * fq;
    float inv[2];
#pragma unroll
    for (int h2 = 0; h2 < 2; ++h2) {
        const float sink2 = h2 ? sinkB : sinkA;
        float mx = sink2;
#pragma unroll
        for (int i = 0; i < 10; ++i)
#pragma unroll
            for (int e = 0; e < 4; ++e) { const int j = jb + 16 * i + e; const bool ok = (j > qi) && (j <= qi + 128) && (j >= jmin); const float v = ok ? s[h2][i][e] : -1e30f; s[h2][i][e] = v; mx = fmaxf(mx, v); }
        mx = fmaxf(mx, __shfl_xor(mx, 16)); mx = fmaxf(mx, __shfl_xor(mx, 32));
        float sum = 0.f;
#pragma unroll
        for (int i = 0; i < 10; ++i)
#pragma unroll
            for (int e = 0; e < 4; ++e) { const float p = ex2(s[h2][i][e] - mx); s[h2][i][e] = p; sum += p; }
        sum += __shfl_xor(sum, 16); sum += __shfl_xor(sum, 32);
        sum += ex2(sink2 - mx);
        inv[h2] = __builtin_amdgcn_rcpf(sum);
    }
    f32x4 o[2][4];
#pragma unroll
    for (int h2 = 0; h2 < 2; ++h2)
#pragma unroll
        for (int d = 0; d < 4; ++d) o[h2][d] = (f32x4){0.f, 0.f, 0.f, 0.f};
    LAS const unsigned char* vbase = Vl + (kb_lo * 16 + 4 * fq + (fr >> 2)) * KS64 + (fr & 3) * 8;
#pragma unroll
    for (int g = 0; g < 5; ++g) {
        const bf16x8 pf0 = as_bf16x8(pack8(s[0][2 * g] * inv[0], s[0][2 * g + 1] * inv[0])), pf1 = as_bf16x8(pack8(s[1][2 * g] * inv[1], s[1][2 * g + 1] * inv[1]));
#pragma unroll
        for (int db = 0; db < 4; ++db) {
            const bf16x4 v0 = trread(vbase + (2 * g) * 16 * KS64 + db * 32), v1 = trread(vbase + (2 * g + 1) * 16 * KS64 + db * 32);
            const bf16x8 vf = cat4(v0, v1);
            o[0][db] = __builtin_amdgcn_mfma_f32_16x16x32_bf16(vf, pf0, o[0][db], 0, 0, 0); o[1][db] = __builtin_amdgcn_mfma_f32_16x16x32_bf16(vf, pf1, o[1][db], 0, 0, 0);
        }
        __builtin_amdgcn_sched_barrier(0);
    }
#pragma unroll
    for (int h2 = 0; h2 < 2; ++h2)
#pragma unroll
        for (int db = 0; db < 4; ++db) { u32x2 w; w.x = pk2(o[h2][db][0], o[h2][db][1]); w.y = pk2(o[h2][db][2], o[h2][db][3]); *(u32x2*)(optr + 64 * h2 + 16 * db + 4 * fq) = w; }
}

__device__ __forceinline__ void swa_prompt_item(const Params& P, LAS unsigned char* lds, int item) {
    unsigned char* ws = P.ws;
    const int tid = threadIdx.x, lane = tid & 63, wave = tid >> 6;
    const int kvh = item & 1, blk = (item >> 1) & 31, b = item >> 6;
    const bf16_t* ka = (const bf16_t*)(ws + WS_KA); const bf16_t* va = (const bf16_t*)(ws + WS_VA);
    LAS unsigned char* Kl = lds; LAS unsigned char* Vl = lds + 256 * KS64;
    __syncthreads();
#pragma unroll
    for (int i = 0; i < 4; ++i) {
        const int c = tid + i * NTHR, row = c >> 3, part = c & 7;
        u32x4 kv = {0u, 0u, 0u, 0u}, vv = {0u, 0u, 0u, 0u};
        if (blk > 0 || row >= 128) { const size_t t = (size_t)b * 4096 + (blk - 1) * 128 + row; kv = *(const u32x4*)(ka + t * 128 + kvh * 64 + part * 8); vv = *(const u32x4*)(va + t * 128 + kvh * 64 + part * 8); }
        *(LAS u32x4*)(Kl + row * KS64 + part * 16) = kv; *(LAS u32x4*)(Vl + row * KS64 + part * 16) = vv;
    }
    __syncthreads();
    const bf16_t* qa = (const bf16_t*)(ws + WS_QA); bf16_t* mix = (bf16_t*)(ws + WS_MIX);
    const int i_in = 16 * wave + (lane & 15);
    const size_t tok = (size_t)b * 4096 + blk * 128 + i_in;
    for (int hh = 0; hh < 4; hh += 2) {
        const int head = kvh * 4 + hh;
        swa_qblock2(Kl, Vl, wave & ~1, qa + tok * 512 + head * 64, mix + tok * 1024 + head * 64, i_in, blk == 0 ? 128 : 0, P.in[12][head] * LOG2E, P.in[12][head + 1] * LOG2E, lane);
    }
}

__device__ __forceinline__ void swa_sample_item(const Params& P, LAS unsigned char* lds, int item) {
    unsigned char* ws = P.ws;
    const int tid = threadIdx.x, lane = tid & 63, wave = tid >> 6;
    const int kvh = item & 1, bs = item >> 1;
    const bf16_t* ka = (const bf16_t*)(ws + WS_KA); const bf16_t* va = (const bf16_t*)(ws + WS_VA);
    const float* ck = P.in[3]; const float* cv = P.in[4];
    LAS unsigned char* Kl = lds; LAS unsigned char* Vl = lds + 256 * KS64;
    __syncthreads();
    for (int c = tid; c < 160 * 8; c += NTHR) {
        const int row = c >> 3, part = c & 7;
        u32x4 kv = {0u, 0u, 0u, 0u}, vv = {0u, 0u, 0u, 0u};
        if (row < 128) {
            const size_t src = ((size_t)(bs * 128 + row) * 2 + kvh) * 64 + part * 8;
            const f32x4 k0 = __builtin_nontemporal_load((const f32x4*)(ck + src)), k1 = __builtin_nontemporal_load((const f32x4*)(ck + src + 4)), v0 = __builtin_nontemporal_load((const f32x4*)(cv + src)), v1 = __builtin_nontemporal_load((const f32x4*)(cv + src + 4));
            kv = pack8(k0, k1); vv = pack8(v0, v1);
            if (row >= 8) { const size_t dst = ((size_t)(bs * 128 + row - 8) * 2 + kvh) * 64 + part * 8;
                __builtin_nontemporal_store(k0, (f32x4*)(P.out + O_SWAKS + dst)); __builtin_nontemporal_store(k1, (f32x4*)(P.out + O_SWAKS + dst + 4)); __builtin_nontemporal_store(v0, (f32x4*)(P.out + O_SWAVS + dst)); __builtin_nontemporal_store(v1, (f32x4*)(P.out + O_SWAVS + dst + 4)); }
        } else if (row < 136) {
            const size_t t = (size_t)TP + bs * 8 + (row - 128);
            kv = *(const u32x4*)(ka + t * 128 + kvh * 64 + part * 8); vv = *(const u32x4*)(va + t * 128 + kvh * 64 + part * 8);
        }
        *(LAS u32x4*)(Kl + row * KS64 + part * 16) = kv; *(LAS u32x4*)(Vl + row * KS64 + part * 16) = vv;
    }
    __syncthreads();
    if (wave < 2) {
        const bf16_t* qa = (const bf16_t*)(ws + WS_QA); bf16_t* mix = (bf16_t*)(ws + WS_MIX);
        const int ridx = 16 * wave + (lane & 15), hh = ridx >> 3, t = ridx & 7, head = kvh * 4 + hh;
        const size_t tok = (size_t)TP + bs * 8 + t;
        swa_qblock(Kl, Vl, 0, qa + tok * 512 + head * 64, mix + tok * 1024 + head * 64, true, t, 0, P.in[12][head] * LOG2E, lane);
    }
}

__device__ __forceinline__ float log2gamma(int h) { return __log2f(1.0f - exp2f(-5.0f - (float)h)); }

__device__ __forceinline__ void ret_local_item(const Params& P, LAS unsigned char* lds, int item) {
    unsigned char* ws = P.ws;
    const int tid = threadIdx.x, lane = tid & 63, wave = tid >> 6, fr = lane & 15, fq = lane >> 4;
    const int c = item & 31, h = (item >> 5) & 7, b = item >> 8;
    const bf16_t* kr = (const bf16_t*)(ws + WS_KR); const bf16_t* vr = (const bf16_t*)(ws + WS_VR);
    LAS unsigned char* Kl = lds; LAS unsigned char* Vl = lds + 128 * KS64;
    const float l2g = log2gamma(h);
    __syncthreads();
#pragma unroll
    for (int i = 0; i < 2; ++i) {
        const int cc = tid + i * NTHR, row = cc >> 3, part = cc & 7;
        const size_t t = (size_t)b * 4096 + c * 128 + row;
        const u32x4 kv = *(const u32x4*)(kr + t * 512 + h * 64 + part * 8), vv = *(const u32x4*)(vr + t * 512 + h * 64 + part * 8);
        const float dk = ex2((float)(127 - row) * l2g);
        u32x4 kd; kd.x = pk2(bflo(kv.x) * dk, bfhi(kv.x) * dk); kd.y = pk2(bflo(kv.y) * dk, bfhi(kv.y) * dk); kd.z = pk2(bflo(kv.z) * dk, bfhi(kv.z) * dk); kd.w = pk2(bflo(kv.w) * dk, bfhi(kv.w) * dk);
        *(LAS u32x4*)(Kl + row * KS64 + part * 16) = kd; *(LAS u32x4*)(Vl + row * KS64 + part * 16) = vv;
    }
    __syncthreads();
    const int eb = wave >> 1;
    f32x4 acc[2] = {{0.f, 0.f, 0.f, 0.f}, {0.f, 0.f, 0.f, 0.f}};
    LAS const unsigned char* vb = Vl + (8 * fq + (fr >> 2)) * KS64 + eb * 32 + (fr & 3) * 8;
    LAS const unsigned char* kb = Kl + (8 * fq + (fr >> 2)) * KS64 + (fr & 3) * 8;
#pragma unroll
    for (int ks = 0; ks < 4; ++ks) {
        const bf16x8 af = cat4(trread(vb + ks * 32 * KS64), trread(vb + ks * 32 * KS64 + 4 * KS64));
#pragma unroll
        for (int dd = 0; dd < 2; ++dd) {
            const int db = 2 * (wave & 1) + dd;
            const bf16x8 bfm = cat4(trread(kb + ks * 32 * KS64 + db * 32), trread(kb + ks * 32 * KS64 + 4 * KS64 + db * 32));
            acc[dd] = __builtin_amdgcn_mfma_f32_16x16x32_bf16(af, bfm, acc[dd], 0, 0, 0);
        }
    }
    float* kvl = (float*)(ws + WS_KVLOC) + (size_t)item * 4096;
#pragma unroll
    for (int dd = 0; dd < 2; ++dd) {
        const int db = 2 * (wave & 1) + dd;
#pragma unroll
        for (int e = 0; e < 4; ++e) kvl[(16 * eb + 4 * fq + e) * 64 + 16 * db + fr] = acc[dd][e];
    }
}

__device__ __forceinline__ void ret_sample_item(const Params& P, LAS unsigned char* lds, int item) {
    unsigned char* ws = P.ws;
    const int tid = threadIdx.x, lane = tid & 63, wave = tid >> 6;
    const int h = item & 7, bs = item >> 3;
    LAS float* ql = (LAS float*)lds; LAS float* kl = ql + 512; LAS float* vl = kl + 512; LAS float* al = vl + 512; LAS float* part = al + 64;
    const float l2g = log2gamma(h);
    __syncthreads();
    {
        const int t = tid >> 6, d = tid & 63; const size_t tok = (size_t)TP + bs * 8 + t;
        ql[tid] = bf2f(((const bf16_t*)(ws + WS_QR))[tok * 512 + h * 64 + d]);
        kl[tid] = bf2f(((const bf16_t*)(ws + WS_KR))[tok * 512 + h * 64 + d]);
        vl[tid] = bf2f(((const bf16_t*)(ws + WS_VR))[tok * 512 + h * 64 + d]);
    }
    __syncthreads();
    if (tid < 64) { const int i = tid >> 3, j = tid & 7; float a = 0.f; for (int d = 0; d < 64; ++d) a += ql[i * 64 + d] * kl[j * 64 + d]; al[tid] = (j <= i) ? a * ex2((float)(i - j) * l2g) : 0.f; }
    const int e = tid & 63, dg = tid >> 6;
    const float* s0p = P.in[5] + ((size_t)(bs * 8 + h) * 64 + dg * 8) * 64 + e;
    float* snp = P.out + O_RETS + ((size_t)(bs * 8 + h) * 64 + dg * 8) * 64 + e;
    float s0[8];
#pragma unroll
    for (int dd = 0; dd < 8; ++dd) s0[dd] = __builtin_nontemporal_load(s0p + dd * 64);
    const float g8 = ex2(8.0f * l2g);
#pragma unroll
    for (int dd = 0; dd < 8; ++dd) {
        float a = s0[dd] * g8;
#pragma unroll
        for (int j = 0; j < 8; ++j) a += ex2((float)(7 - j) * l2g) * kl[j * 64 + dg * 8 + dd] * vl[j * 64 + e];
        __builtin_nontemporal_store(a, snp + dd * 64);
    }
#pragma unroll
    for (int i = 0; i < 8; ++i) {
        float a = 0.f;
#pragma unroll
        for (int dd = 0; dd < 8; ++dd) a += ql[i * 64 + dg * 8 + dd] * s0[dd];
        part[(dg * 8 + i) * 64 + e] = a;
    }
    __syncthreads();
    {
        const int i = wave;
        float o = 0.f;
#pragma unroll
        for (int g = 0; g < 8; ++g) o += part[(g * 8 + i) * 64 + e];
        o *= ex2((float)(i + 1) * l2g);
#pragma unroll
        for (int j = 0; j < 8; ++j) o += al[i * 8 + j] * vl[j * 64 + e];
        float ss = o * o;
#pragma unroll
        for (int x = 1; x < 64; x <<= 1) ss += __shfl_xor(ss, x);
        const float rn = __builtin_amdgcn_rsqf(ss * (1.0f / 64.0f) + EPS);
        const size_t tok = (size_t)TP + bs * 8 + i;
        const float gate = bf2f(((const bf16_t*)(ws + WS_GS))[tok * 512 + h * 64 + e]);
        ((bf16_t*)(ws + WS_MIX))[tok * 1024 + 512 + h * 64 + e] = (bf16_t)(pk2(o * rn * gate, 0.f) & 0xffffu);
    }
}

__device__ __forceinline__ void memk_item(const Params& P, int item) {
    unsigned char* ws = P.ws;
    const int tid = threadIdx.x, lane = tid & 63, wave = tid >> 6;
    const float* gk = P.in[19]; const float* gq = P.in[18];
#pragma unroll
    for (int i = 0; i < 4; ++i) {
        const int pair = item * 32 + wave * 4 + i;
        float* p = P.out + O_MEMKP + (size_t)pair * 128 + 2 * lane;
        f32x2 v = *(f32x2*)p;
        float ss = v[0] * v[0] + v[1] * v[1];
#pragma unroll
        for (int x = 1; x < 64; x <<= 1) ss += __shfl_xor(ss, x);
        const float rn = __builtin_amdgcn_rsqf(ss * (1.0f / 128.0f) + EPS);
        v[0] = v[0] * rn * gk[2 * lane]; v[1] = v[1] * rn * gk[2 * lane + 1];
        __builtin_nontemporal_store(v, (f32x2*)p);
        ((unsigned*)(ws + WS_MKB))[(size_t)pair * 64 + lane] = pk2(v[0] * gq[2 * lane], v[1] * gq[2 * lane + 1]);
    }
}

__device__ __forceinline__ void phase2(const Params& P, LAS unsigned char* lds) {
    for (int it = blockIdx.x; it < 4096; it += gridDim.x) {
        if (it < 512) swa_prompt_item(P, lds, it);
        else if (it < 768) swa_sample_item(P, lds, it - 512);
        else if (it < 2816) ret_local_item(P, lds, it - 768);
        else if (it < 3840) ret_sample_item(P, lds, it - 2816);
        else memk_item(P, it - 3840);
    }
}

__device__ __forceinline__ void phase3(const Params& P, int wg, int nwg) {
    unsigned char* ws = P.ws;
    const float* kvl = (const float*)(ws + WS_KVLOC); bf16_t* st = (bf16_t*)(ws + WS_ST);
    for (int el = wg * NTHR + threadIdx.x; el < 64 * 4096; el += nwg * NTHR) {
        const int bh = el >> 12, idx = el & 4095, e = idx >> 6, d = idx & 63, h = bh & 7;
        const float g128 = ex2(128.0f * log2gamma(h));
        float S = 0.f;
#pragma unroll 8
        for (int c = 0; c < 32; ++c) {
            const size_t o = ((size_t)(bh * 32 + c)) * 4096 + idx;
            st[o] = (bf16_t)(pk2(S, 0.f) & 0xffffu);
            S = S * g128 + __builtin_nontemporal_load(kvl + o);
        }
        P.out[O_RETP + ((size_t)bh * 64 + d) * 64 + e] = S;
    }
}

__device__ __forceinline__ void ret_out_item(const Params& P, LAS unsigned char* lds, int item) {
    unsigned char* ws = P.ws;
    const int tid = threadIdx.x, lane = tid & 63, wave = tid >> 6, fr = lane & 15, fq = lane >> 4;
    const int c = item & 31, h = (item >> 5) & 7, b = item >> 8;
    const bf16_t* qr = (const bf16_t*)(ws + WS_QR); const bf16_t* kr = (const bf16_t*)(ws + WS_KR); const bf16_t* vr = (const bf16_t*)(ws + WS_VR);
    LAS unsigned char* Kl = lds; LAS unsigned char* Vl = lds + 128 * KS64; LAS unsigned char* Sl = Vl + 128 * KS64;
    const float l2g = log2gamma(h);
    __syncthreads();
#pragma unroll
    for (int i = 0; i < 2; ++i) {
        const int cc = tid + i * NTHR, row = cc >> 3, part = cc & 7;
        const size_t t = (size_t)b * 4096 + c * 128 + row;
        *(LAS u32x4*)(Kl + row * KS64 + part * 16) = __builtin_nontemporal_load((const u32x4*)(kr + t * 512 + h * 64 + part * 8));
        *(LAS u32x4*)(Vl + row * KS64 + part * 16) = __builtin_nontemporal_load((const u32x4*)(vr + t * 512 + h * 64 + part * 8));
    }
    { const int row = tid >> 3, part = tid & 7; *(LAS u32x4*)(Sl + row * KS64 + part * 16) = __builtin_nontemporal_load((const u32x4*)((const bf16_t*)(ws + WS_ST) + (size_t)item * 4096 + row * 64 + part * 8)); }
    __syncthreads();
    const int i_in = 16 * wave + fr;
    const size_t tok = (size_t)b * 4096 + c * 128 + i_in;
    const bf16_t* qptr = qr + tok * 512 + h * 64;
    bf16x8 qf[2]; qf[0] = __builtin_nontemporal_load((const bf16x8*)(qptr + 8 * fq)); qf[1] = __builtin_nontemporal_load((const bf16x8*)(qptr + 32 + 8 * fq));
    f32x4 s[8];
    LAS const unsigned char* kbase = Kl + fr * KS64 + fq * 16;
#pragma unroll
    for (int kb = 0; kb < 8; ++kb) {
        f32x4 a = {0.f, 0.f, 0.f, 0.f};
        if (kb <= wave) {
#pragma unroll
            for (int ks = 0; ks < 2; ++ks) { const bf16x8 kf = *(LAS const bf16x8*)(kbase + kb * 16 * KS64 + ks * 64); a = __builtin_amdgcn_mfma_f32_16x16x32_bf16(kf, qf[ks], a, 0, 0, 0); }
#pragma unroll
            for (int e = 0; e < 4; ++e) { const int diff = i_in - (16 * kb + 4 * fq + e); a[e] = diff >= 0 ? a[e] * ex2((float)diff * l2g) : 0.f; }
        }
        s[kb] = a;
    }
    f32x4 o[4], oc[4];
#pragma unroll
    for (int d = 0; d < 4; ++d) { o[d] = (f32x4){0.f, 0.f, 0.f, 0.f}; oc[d] = (f32x4){0.f, 0.f, 0.f, 0.f}; }
    LAS const unsigned char* vbase = Vl + (4 * fq + (fr >> 2)) * KS64 + (fr & 3) * 8;
#pragma unroll
    for (int g = 0; g < 4; ++g) {
        if (2 * g <= wave) {
            const bf16x8 pf = as_bf16x8(pack8(s[2 * g], s[2 * g + 1]));
#pragma unroll
            for (int db = 0; db < 4; ++db) {
                const bf16x4 v0 = trread(vbase + (2 * g) * 16 * KS64 + db * 32), v1 = trread(vbase + (2 * g + 1) * 16 * KS64 + db * 32);
                o[db] = __builtin_amdgcn_mfma_f32_16x16x32_bf16(cat4(v0, v1), pf, o[db], 0, 0, 0);
            }
        }
    }
    LAS const unsigned char* sbase = Sl + fr * KS64 + fq * 16;
#pragma unroll
    for (int db = 0; db < 4; ++db)
#pragma unroll
        for (int ks = 0; ks < 2; ++ks) { const bf16x8 sf = *(LAS const bf16x8*)(sbase + db * 16 * KS64 + ks * 64); oc[db] = __builtin_amdgcn_mfma_f32_16x16x32_bf16(sf, qf[ks], oc[db], 0, 0, 0); }
    const float qd = ex2((float)(i_in + 1) * l2g);
    float ss = 0.f;
#pragma unroll
    for (int db = 0; db < 4; ++db) { o[db] = o[db] + oc[db] * qd; ss += dot4(o[db]); }
    ss += __shfl_xor(ss, 16); ss += __shfl_xor(ss, 32);
    const float rn = __builtin_amdgcn_rsqf(ss * (1.0f / 64.0f) + EPS);
    const bf16_t* gp = (const bf16_t*)(ws + WS_GS) + tok * 512 + h * 64 + 4 * fq;
    bf16_t* op = (bf16_t*)(ws + WS_MIX) + tok * 1024 + 512 + h * 64 + 4 * fq;
#pragma unroll
    for (int db = 0; db < 4; ++db) {
        const u32x2 gw = __builtin_nontemporal_load((const u32x2*)(gp + 16 * db));
        u32x2 w; w.x = pk2(o[db][0] * rn * bflo(gw.x), o[db][1] * rn * bfhi(gw.x)); w.y = pk2(o[db][2] * rn * bflo(gw.y), o[db][3] * rn * bfhi(gw.y));
        *(u32x2*)(op + 16 * db) = w;
    }
}
__device__ __forceinline__ void phase4(const Params& P, LAS unsigned char* lds, int first, int stride, int last) {
    for (int it = first; it < last; it += stride) ret_out_item(P, lds, it);
}

__device__ __forceinline__ void mem_qblock(LAS const unsigned char* Kl, LAS const unsigned char* Vl, const bf16_t* qptr, float sc, bf16_t* optr, bool do_store, int lane) {
    const int fr = lane & 15, fq = lane >> 4;
    bf16x8 qf[4];
#pragma unroll
    for (int ks = 0; ks < 4; ++ks) qf[ks] = __builtin_nontemporal_load((const bf16x8*)(qptr + 32 * ks + 8 * fq));
    f32x4 s[16];
    LAS const unsigned char* kbase = Kl + fr * KS128 + fq * 16;
#pragma unroll
    for (int i = 0; i < 16; ++i) {
        f32x4 a = {0.f, 0.f, 0.f, 0.f};
#pragma unroll
        for (int ks = 0; ks < 4; ++ks) { const bf16x8 kf = *(LAS const bf16x8*)(kbase + i * 16 * KS128 + ks * 64); a = __builtin_amdgcn_mfma_f32_16x16x32_bf16(kf, qf[ks], a, 0, 0, 0); }
        s[i] = a * sc;
        if (i & 1) __builtin_amdgcn_sched_barrier(0);
    }
    float mx = -1e30f;
#pragma unroll
    for (int i = 0; i < 16; ++i) mx = fmaxf(fmaxf(mx, fmaxf(s[i][0], s[i][1])), fmaxf(s[i][2], s[i][3]));
    mx = fmaxf(mx, __shfl_xor(mx, 16)); mx = fmaxf(mx, __shfl_xor(mx, 32));
    float sum = 0.f;
#pragma unroll
    for (int i = 0; i < 16; ++i)
#pragma unroll
        for (int e = 0; e < 4; ++e) { const float p = ex2(s[i][e] - mx); s[i][e] = p; sum += p; }
    sum += __shfl_xor(sum, 16); sum += __shfl_xor(sum, 32);
    const float inv = __builtin_amdgcn_rcpf(sum);
    f32x4 o[8];
#pragma unroll
    for (int d = 0; d < 8; ++d) o[d] = (f32x4){0.f, 0.f, 0.f, 0.f};
    LAS const unsigned char* vbase = Vl + (4 * fq + (fr >> 2)) * KS128 + (fr & 3) * 8;
#pragma unroll
    for (int g = 0; g < 8; ++g) {
        const bf16x8 pf = as_bf16x8(pack8(s[2 * g] * inv, s[2 * g + 1] * inv));
#pragma unroll
        for (int db = 0; db < 8; ++db) {
            const bf16x4 v0 = trread(vbase + (2 * g) * 16 * KS128 + db * 32), v1 = trread(vbase + (2 * g + 1) * 16 * KS128 + db * 32);
            o[db] = __builtin_amdgcn_mfma_f32_16x16x32_bf16(cat4(v0, v1), pf, o[db], 0, 0, 0);
        }
        __builtin_amdgcn_sched_barrier(0);
    }
    if (do_store) {
#pragma unroll
        for (int db = 0; db < 8; ++db) { u32x2 w; w.x = pk2(o[db][0], o[db][1]); w.y = pk2(o[db][2], o[db][3]); *(u32x2*)(optr + 16 * db + 4 * fq) = w; }
    }
}
constexpr float MEM_SC = 0.08838834764831845f * LOG2E;

__device__ __forceinline__ void mem_prompt_item(const Params& P, LAS unsigned char* lds, int item) {
    unsigned char* ws = P.ws;
    const int tid = threadIdx.x, lane = tid & 63, wave = tid >> 6;
    const int qt = item & 7, h = (item >> 3) & 3, b = item >> 5;
    const bf16_t* mkb = (const bf16_t*)(ws + WS_MKB); const bf16_t* mvb = (const bf16_t*)(ws + WS_MVB);
    LAS unsigned char* Kl = lds; LAS unsigned char* Vl = lds + 256 * KS128;
    __syncthreads();
#pragma unroll
    for (int i = 0; i < 8; ++i) {
        const int cc = tid + i * NTHR, row = cc >> 4, part = cc & 15;
        const size_t src = ((size_t)(b * 256 + row)) * 512 + h * 128 + part * 8;
        *(LAS u32x4*)(Kl + row * KS128 + part * 16) = *(const u32x4*)(mkb + src);
        *(LAS u32x4*)(Vl + row * KS128 + part * 16) = *(const u32x4*)(mvb + src);
    }
    __syncthreads();
    const bf16_t* qm = (const bf16_t*)(ws + WS_QM); const float* ssqm = (const float*)(ws + WS_SSQM); bf16_t* om = (bf16_t*)(ws + WS_OM);
    for (int qq = 0; qq < 4; ++qq) {
        const size_t tok = (size_t)b * 4096 + qt * 512 + (qq * 8 + wave) * 16 + (lane & 15);
        const float rq = __builtin_amdgcn_rsqf((ssqm[(size_t)(2 * h) * TT + tok] + ssqm[(size_t)(2 * h + 1) * TT + tok]) * (1.0f / 128.0f) + EPS);
        mem_qblock(Kl, Vl, qm + tok * 512 + h * 128, rq * MEM_SC, om + tok * 512 + h * 128, true, lane);
    }
}
__device__ __forceinline__ void mem_sample_item(const Params& P, LAS unsigned char* lds, int item) {
    unsigned char* ws = P.ws;
    const int tid = threadIdx.x, lane = tid & 63, wave = tid >> 6;
    const int h = item & 3, bs = item >> 2;
    const float* ck = P.in[6]; const float* cv = P.in[7]; const float* gq = P.in[18];
    LAS unsigned char* Kl = lds; LAS unsigned char* Vl = lds + 256 * KS128;
    __syncthreads();
    {
        const int part = tid & 15;
        const f32x4 g0 = *(const f32x4*)(gq + part * 8), g1 = *(const f32x4*)(gq + part * 8 + 4);
#pragma unroll
        for (int i = 0; i < 8; ++i) {
            const int row = (tid >> 4) + i * 32;
            const size_t src = ((size_t)(bs * 256 + row) * 4 + h) * 128 + part * 8;
            const f32x4 k0 = __builtin_nontemporal_load((const f32x4*)(ck + src)), k1 = __builtin_nontemporal_load((const f32x4*)(ck + src + 4)), v0 = __builtin_nontemporal_load((const f32x4*)(cv + src)), v1 = __builtin_nontemporal_load((const f32x4*)(cv + src + 4));
            *(LAS u32x4*)(Kl + row * KS128 + part * 16) = pack8(k0 * g0, k1 * g1);
            *(LAS u32x4*)(Vl + row * KS128 + part * 16) = pack8(v0, v1);
        }
    }
    __syncthreads();
    if (wave == 0) {
        const bf16_t* qm = (const bf16_t*)(ws + WS_QM); const float* ssqm = (const float*)(ws + WS_SSQM); bf16_t* om = (bf16_t*)(ws + WS_OM);
        const int r = lane & 15;
        const size_t tok = (size_t)TP + bs * 8 + (r & 7);
        const float rq = __builtin_amdgcn_rsqf((ssqm[(size_t)(2 * h) * TT + tok] + ssqm[(size_t)(2 * h + 1) * TT + tok]) * (1.0f / 128.0f) + EPS);
        mem_qblock(Kl, Vl, qm + tok * 512 + h * 128, rq * MEM_SC, om + tok * 512 + h * 128, r < 8, lane);
    }
}
__device__ __forceinline__ void phase7(const Params& P, LAS unsigned char* lds) {
    for (int it = blockIdx.x; it < 768; it += gridDim.x) {
        if (it < 256) mem_prompt_item(P, lds, it);
        else mem_sample_item(P, lds, it - 256);
    }
}


#define XB_TMO      128
#define XB_XCNT(j)  (256  + 64 * (j))
#define XB_XSUB(j)  (1280 + 64 * (j))
#define XB_XGEN(j)  (2304 + 64 * (j))
#define XB_TOP      3328
#define XB_TOPGEN   3392
#define XCD_BAR_WORDS 3456
#define XB_SPIN_CAP (1u << 18)
constexpr size_t WS_BAR = WS_END + 4096;
__device__ __forceinline__ unsigned xb_ld(unsigned* p)              { return __hip_atomic_load(p, __ATOMIC_RELAXED, __HIP_MEMORY_SCOPE_AGENT); }
__device__ __forceinline__ unsigned xb_add(unsigned* p, unsigned v) { return __hip_atomic_fetch_add(p, v, __ATOMIC_RELAXED, __HIP_MEMORY_SCOPE_AGENT); }
__device__ __forceinline__ unsigned xb_xcc_id() { return (unsigned)__builtin_amdgcn_s_getreg((3 << 11) | 20) & 0xFu; }
#define XB_SPIN(cond, bar) do { unsigned _sp = 0; while (cond) { __builtin_amdgcn_s_sleep(1); \
    if ((++_sp & 255u) == 0u) { if (xb_ld(&(bar)[XB_TMO])) break; if (_sp > XB_SPIN_CAP) { atomicAdd(&(bar)[XB_TMO], 1u); break; } } } } while (0)
struct XcdBarrier { unsigned* bar; unsigned x; volatile LAS unsigned* st; };
__device__ __forceinline__ XcdBarrier xcd_barrier_post(unsigned* bar, volatile LAS unsigned* st) {
    XcdBarrier b; b.bar = bar; b.x = xb_xcc_id(); b.st = st;
    if (threadIdx.x == 0) (void)xb_add(&bar[XB_XCNT(b.x)], 1u);
    return b;
}
__device__ __forceinline__ void xcd_barrier_complete(unsigned* bar, unsigned x, unsigned& nloc, unsigned& nx) {
    const unsigned G = gridDim.x * gridDim.y * gridDim.z;
    unsigned sum, cnt, mine, sp = 0u;
    for (;;) {
        sum = 0u; cnt = 0u; mine = 0u;
#pragma unroll
        for (unsigned j = 0; j < 16; ++j) { const unsigned c = xb_ld(&bar[XB_XCNT(j)]); sum += c; cnt += (c > 0u) ? 1u : 0u; mine = (j == x) ? c : mine; }
        if (sum == G) break;
        __builtin_amdgcn_s_sleep(1);
        if ((++sp & 255u) == 0u) { if (xb_ld(&bar[XB_TMO])) break; if (sp > XB_SPIN_CAP) { atomicAdd(&bar[XB_TMO], 1u); break; } }
    }
    nloc = mine > 0u ? mine : 1u; nx = cnt > 0u ? cnt : 1u;
}
__device__ __forceinline__ void xcd_barrier(const XcdBarrier& b) {
    asm volatile("s_waitcnt vmcnt(0)" ::: "memory");
    __syncthreads();
    if (threadIdx.x == 0) {
        unsigned* bar = b.bar;
        __builtin_amdgcn_s_waitcnt(0);
        unsigned nloc = b.st[0], nx = b.st[1];
        if (nloc == 0u) { xcd_barrier_complete(bar, b.x, nloc, nx); b.st[0] = nloc; b.st[1] = nx; }
        const unsigned old = xb_add(&bar[XB_XSUB(b.x)], 1u);
        const unsigned gen = old / nloc;
        if (old + 1u == (gen + 1u) * nloc) {
            __builtin_amdgcn_fence(__ATOMIC_RELEASE, "agent");
            asm volatile("s_waitcnt vmcnt(0)" ::: "memory");
            const unsigned og = xb_add(&bar[XB_TOP], 1u);
            const unsigned tg = og / nx;
            if (og + 1u == (tg + 1u) * nx) xb_add(&bar[XB_TOPGEN], 1u);
            else XB_SPIN(xb_ld(&bar[XB_TOPGEN]) == tg, bar);
            __builtin_amdgcn_fence(__ATOMIC_ACQUIRE, "agent");
            xb_add(&bar[XB_XGEN(b.x)], 1u);
            asm volatile("s_waitcnt vmcnt(0)" ::: "memory");
        } else {
            XB_SPIN(xb_ld(&bar[XB_XGEN(b.x)]) == gen, bar);
            __builtin_amdgcn_fence(__ATOMIC_ACQUIRE, "agent");
            asm volatile("s_waitcnt vmcnt(0)" ::: "memory");
        }
    }
    __syncthreads();
}

__global__ void __launch_bounds__(NTHR) fwd_kernel(Params P) {
    __shared__ __attribute__((aligned(16))) unsigned char smem[LDS_BYTES];
    LAS unsigned char* lds = (LAS unsigned char*)smem;
    asm volatile("" : "+s"(lds));
    unsigned char* ws = P.ws;
    const int G = gridDim.x, cid = blockIdx.x;
#if ONE_LAUNCH
    cg::grid_group grid = cg::this_grid();
    if (P.hi > 1000) grid.sync();
    volatile LAS unsigned* bst = (volatile LAS unsigned*)(lds + LDS_BYTES - 16);
    if (threadIdx.x == 0) { bst[0] = 0u; bst[1] = 0u; }
    __syncthreads();
    const XcdBarrier xbar = xcd_barrier_post((unsigned*)(ws + WS_BAR), bst);
#define SEAM(k) do { if (P.lo <= (k) && (k) + 1 < P.hi) xcd_barrier(xbar); } while (0)
#else
#define SEAM(k) do { } while (0)
#endif
#ifndef PHMASK
#define PHMASK 0x7ff
#endif
#define IN(k) (((PHMASK >> (k)) & 1) && P.lo <= (k) && (k) < P.hi)
    if (IN(0)) { phase0(P); } SEAM(0);
    if (IN(1)) {
        pg8::Sched S; S.init(ws + WS_XB, ws + WS_WIN, TT, 2816, 1024, G, cid); S.extra(ws + WS_MEMB, ws + WS_WMKV, 2048, 1024);
        EpiA E{ws, P.in[10], P.in[11], P.out};
        pg8::gemm_phase<EpiA>(lds, 1024, S, E);
    } SEAM(1);
    if (IN(2)) { phase2(P, lds); } SEAM(2);
    const bool early = ONE_LAUNCH && G == 256 && P.lo == 0 && P.hi == 11;
    if (IN(3)) {
        if (early && cid >= 240) {
            const int u0 = cid - 240, pm = 128 + (u0 & 3), pn = u0 >> 2;
            SchedOne S1{(const char*)(ws + WS_MIX) + (size_t)pm * 256 * 1024 * 2, (const char*)(ws + WS_WOUT) + (size_t)pn * 256 * 1024 * 2, pm, pn, true};
            EpiRes<1> E{nullptr, nullptr, P.out, (bf16_t*)(ws + WS_XB), (float*)(ws + WS_SSQ1)};
            pg8::gemm_phase<EpiRes<1>, SchedOne>(lds, 1024, S1, E);
        } else phase3(P, cid, early ? 240 : G);
    } SEAM(3);
    if (IN(4)) {
        if (early && cid >= 248) {
            const int u0 = cid - 248, pm = 128 + (u0 & 3), pn = u0 >> 2;
            SchedOne S1{(const char*)(ws + WS_XB) + (size_t)pm * 256 * 1024 * 2, (const char*)(ws + WS_WMQ) + (size_t)pn * 256 * 1024 * 2, pm, pn, true};
            EpiMq E{(const float*)(ws + WS_SSQ1), (bf16_t*)(ws + WS_QM), (float*)(ws + WS_SSQM)};
            pg8::gemm_phase<EpiMq, SchedOne>(lds, 1024, S1, E);
            phase4(P, lds, 2024 + u0 * 3, 1, 2024 + u0 * 3 + 3);
        } else if (early) phase4(P, lds, cid, 248, 2024);
        else phase4(P, lds, cid, G, 2048);
        __syncthreads();
    } SEAM(4);
    if (IN(5)) {
        pg8::Sched S; S.init(ws + WS_MIX, ws + WS_WOUT, early ? TP : TT, 1024, 1024, G, cid);
        EpiRes<1> E{nullptr, nullptr, P.out, (bf16_t*)(ws + WS_XB), (float*)(ws + WS_SSQ1)};
        pg8::gemm_phase<EpiRes<1>>(lds, 1024, S, E);
    } SEAM(5);
    if (IN(6)) {
        pg8::Sched S; S.init(ws + WS_XB, ws + WS_WMQ, early ? TP : TT, 512, 1024, G, cid);
        EpiMq E{(const float*)(ws + WS_SSQ1), (bf16_t*)(ws + WS_QM), (float*)(ws + WS_SSQM)};
        pg8::gemm_phase<EpiMq>(lds, 1024, S, E);
    } SEAM(6);
    if (IN(7)) { phase7(P, lds); __syncthreads(); } SEAM(7);
    if (IN(8)) {
        pg8::Sched S; S.init(ws + WS_OM, ws + WS_WMO, TT, 1024, 512, G, cid);
        EpiRes<1> E{nullptr, nullptr, P.out, (bf16_t*)(ws + WS_XB), (float*)(ws + WS_SSQ2)};
        pg8::gemm_phase<EpiRes<1>>(lds, 512, S, E);
    } SEAM(8);
    unsigned* const hid_ready = (unsigned*)(ws + WS_BAR) + XCD_BAR_WORDS + 64;
    if (IN(9)) {
        SchedGu S; S.P.init(ws + WS_XB, ws + WS_WGU, TP, 5632, 1024, G, cid); S.G = G; S.c = cid; S.A = (const char*)(ws + WS_XB); S.B = (const char*)(ws + WS_WGU);
        EpiGu E{(const float*)(ws + WS_SSQ2), (bf16_t*)(ws + WS_HID), hid_ready};
        pg8::gemm_phase<EpiGu, SchedGu>(lds, 1024, S, E);
#if ONE_LAUNCH
        {
            const int u0 = (G == 256 && P.hi > 10) ? cid - 240 : -1;
            if (u0 >= 0 && u0 < 16) {
                if (threadIdx.x < 64) { unsigned sp = 0; while (__hip_atomic_load(hid_ready, __ATOMIC_RELAXED, __HIP_MEMORY_SCOPE_AGENT) < 704u && ++sp < (1u << 22)) __builtin_amdgcn_s_sleep(2);
                    __builtin_amdgcn_fence(__ATOMIC_ACQUIRE, "agent"); asm volatile("s_waitcnt vmcnt(0)" ::: "memory"); }
                __syncthreads();
                SchedDnTail ST{(const char*)(ws + WS_HID), (const char*)(ws + WS_WDN), u0};
                EpiRes<2> ET{nullptr, nullptr, P.out, (bf16_t*)(ws + WS_XB), nullptr};
                pg8::gemm_phase<EpiRes<2>, SchedDnTail>(lds, 2816, ST, ET);
            }
        }
#endif
    } SEAM(9);
    if (IN(10)) {
        const bool tail_done = ONE_LAUNCH && G == 256 && P.lo <= 9;
        pg8::Sched S; S.init(ws + WS_HID, ws + WS_WDN, tail_done ? TP : TT, 1024, 2816, G, cid);
        EpiRes<2> E{nullptr, nullptr, P.out, (bf16_t*)(ws + WS_XB), nullptr};
        pg8::gemm_phase<EpiRes<2>>(lds, 2816, S, E);
    }
}

extern "C" void kernel_launch(void* const* d_in, const int* in_sizes, int n_in, void* d_out, int out_size, void* d_ws, size_t ws_size, hipStream_t stream) {
    static int grid = 0;
    if (grid == 0) {
        if (n_in != 24 || (size_t)out_size != O_END || ws_size < WS_TOTAL) { fprintf(stderr, "kernel_launch: unexpected sizes n_in %d out %d (want %zu) ws %zu (want %zu)\n", n_in, out_size, (size_t)O_END, ws_size, (size_t)WS_END); grid = -1; return; }
        int dev = 0, cus = 0, per_cu = 0;
        hipGetDevice(&dev);
        hipDeviceGetAttribute(&cus, hipDeviceAttributeMultiprocessorCount, dev);
        hipOccupancyMaxActiveBlocksPerMultiprocessor(&per_cu, (const void*)fwd_kernel, NTHR, 0);
        if (per_cu < 1) { fprintf(stderr, "kernel_launch: occupancy query says %d blocks per CU\n", per_cu); per_cu = 1; }
        (void)hipGetLastError();
        grid = cus * per_cu;
    }
    if (grid < 0) return;
    Params p{};
    for (int i = 0; i < 24; ++i) p.in[i] = (const float*)d_in[i];
    p.out = (float*)d_out; p.ws = (unsigned char*)d_ws;
#if ONE_LAUNCH
    p.lo = 0; p.hi = 11;
    if (hipMemsetAsync((char*)d_ws + WS_BAR, 0, (XCD_BAR_WORDS + 128) * 4, stream) != hipSuccess) { fprintf(stderr, "kernel_launch: memset of barrier words failed\n"); return; }
    void* args[] = {&p};
    hipError_t e = hipLaunchCooperativeKernel((const void*)fwd_kernel, dim3(grid), dim3(NTHR), args, 0, stream);
    if (e != hipSuccess) fprintf(stderr, "cooperative launch failed: %s (grid %d)\n", hipGetErrorString(e), grid);
#else
    for (int ph = 0; ph < 11; ++ph) { p.lo = ph; p.hi = ph + 1; hipLaunchKernelGGL(fwd_kernel, dim3(grid), dim3(NTHR), 0, stream, p); }
#endif
}
```

```cpp
#include <hip/hip_runtime.h>
#include <hip/hip_cooperative_groups.h>
#include <cstdio>
namespace cg = cooperative_groups;

#define LAS __attribute__((address_space(3)))
typedef unsigned short bf16_t;
typedef short bf16x8 __attribute__((ext_vector_type(8)));
typedef short bf16x4 __attribute__((ext_vector_type(4)));
typedef float f32x4 __attribute__((ext_vector_type(4)));
typedef float f32x2 __attribute__((ext_vector_type(2)));
typedef unsigned u32x4 __attribute__((ext_vector_type(4)));
typedef unsigned u32x2 __attribute__((ext_vector_type(2)));

#ifndef ONE_LAUNCH
#define ONE_LAUNCH 1
#endif

constexpr int NTHR = 512;
constexpr int TP = 32768, TS = 1024, TT = TP + TS;
constexpr int NPOS = 4104;
constexpr float EPS = 1e-6f;
constexpr float LOG2E = 1.4426950408889634f;
constexpr int LDS_BYTES = 147456;

constexpr size_t O_SWAKP = (size_t)TT * 1024;
constexpr size_t O_SWAVP = O_SWAKP + 131072;
constexpr size_t O_RETP = O_SWAVP + 131072;
constexpr size_t O_MEMKP = O_RETP + 262144;
constexpr size_t O_MEMVP = O_MEMKP + 1048576;
constexpr size_t O_SWAKS = O_MEMVP + 1048576;
constexpr size_t O_SWAVS = O_SWAKS + 2097152;
constexpr size_t O_RETS = O_SWAVS + 2097152;
constexpr size_t O_END = O_RETS + 4194304;

constexpr size_t WS_WIN = 0;
constexpr size_t WS_WOUT = WS_WIN + (size_t)2816 * 1024 * 2;
constexpr size_t WS_WMQ = WS_WOUT + (size_t)1024 * 1024 * 2;
constexpr size_t WS_WMKV = WS_WMQ + (size_t)512 * 1024 * 2;
constexpr size_t WS_WMO = WS_WMKV + (size_t)1024 * 1024 * 2;
constexpr size_t WS_WGU = WS_WMO + (size_t)1024 * 512 * 2;
constexpr size_t WS_WDN = WS_WGU + (size_t)5632 * 1024 * 2;
constexpr size_t WS_XB = WS_WDN + (size_t)1024 * 2816 * 2;
constexpr size_t WS_MEMB = WS_XB + (size_t)TT * 1024 * 2;
constexpr size_t WS_RSTD0 = WS_MEMB + (size_t)2048 * 1024 * 2;
constexpr size_t WS_RSTDM = WS_RSTD0 + (size_t)TT * 4;
constexpr size_t WS_ROPE = WS_RSTDM + 2048 * 4;
constexpr size_t ROPE_T = (size_t)NPOS * 32 * 4;
constexpr size_t WS_QA = WS_ROPE + 4 * ROPE_T;
constexpr size_t WS_KA = WS_QA + (size_t)TT * 512 * 2;
constexpr size_t WS_VA = WS_KA + (size_t)TT * 128 * 2;
constexpr size_t WS_QR = WS_VA + (size_t)TT * 128 * 2;
constexpr size_t WS_KR = WS_QR + (size_t)TT * 512 * 2;
constexpr size_t WS_VR = WS_KR + (size_t)TT * 512 * 2;
constexpr size_t WS_GS = WS_VR + (size_t)TT * 512 * 2;
constexpr size_t WS_HID = WS_QA;
constexpr size_t WS_MIX = WS_GS + (size_t)TT * 512 * 2;
constexpr size_t WS_OM = WS_MIX + (size_t)TT * 512 * 2;
constexpr size_t WS_KVLOC = WS_MIX + (size_t)TT * 1024 * 2;
constexpr size_t WS_ST = WS_KVLOC + (size_t)2048 * 4096 * 4;
constexpr size_t WS_SSQ1 = WS_ST + (size_t)2048 * 4096 * 2;
constexpr size_t WS_SSQ2 = WS_SSQ1 + (size_t)TT * 16 * 4;
constexpr size_t WS_SSQM = WS_SSQ2 + (size_t)TT * 16 * 4;
constexpr size_t WS_MKB = WS_SSQM + (size_t)TT * 8 * 4;
constexpr size_t WS_MVB = WS_MKB + (size_t)2048 * 512 * 2;
constexpr size_t WS_END = WS_MVB + (size_t)2048 * 512 * 2;
constexpr size_t WS_QM = WS_END + (1u << 20);
constexpr size_t WS_TOTAL = WS_QM + (size_t)TT * 512 * 2;

struct Params { const float* in[24]; float* out; unsigned char* ws; int lo, hi; };

typedef __bf16 bf16n2 __attribute__((ext_vector_type(2)));
__device__ __forceinline__ unsigned pk2(float a, float b) { const f32x2 v = {a, b}; union { bf16n2 h; unsigned u; } c; c.h = __builtin_convertvector(v, bf16n2); return c.u; }
__device__ __forceinline__ float bf2f(unsigned short h) { return __uint_as_float(((unsigned)h) << 16); }
__device__ __forceinline__ float bflo(unsigned w) { return __uint_as_float(w << 16); }
__device__ __forceinline__ float bfhi(unsigned w) { return __uint_as_float(w & 0xffff0000u); }
__device__ __forceinline__ u32x4 pack8(f32x4 a, f32x4 b) { u32x4 w; w.x = pk2(a[0], a[1]); w.y = pk2(a[2], a[3]); w.z = pk2(b[0], b[1]); w.w = pk2(b[2], b[3]); return w; }
__device__ __forceinline__ bf16x8 as_bf16x8(u32x4 w) { union { u32x4 u; bf16x8 b; } c; c.u = w; return c.b; }
__device__ __forceinline__ float dot4(f32x4 a) { return (a[0] * a[0] + a[1] * a[1]) + (a[2] * a[2] + a[3] * a[3]); }
__device__ __forceinline__ float ex2(float x) { return __builtin_amdgcn_exp2f(x); }
__device__ __forceinline__ float silu(float x) { return x * __builtin_amdgcn_rcpf(1.0f + ex2(-x * LOG2E)); }
__device__ __forceinline__ bf16x4 trread(LAS const unsigned char* p) { return __builtin_amdgcn_ds_read_tr16_b64_v4i16((LAS bf16x4*)p); }
__device__ __forceinline__ bf16x8 cat4(bf16x4 a, bf16x4 b) { return __builtin_shufflevector(a, b, 0, 1, 2, 3, 4, 5, 6, 7); }
__device__ __forceinline__ int posidx(int row) { return row < TP ? (row & 4095) : 4096 + ((row - TP) & 7); }
__device__ __forceinline__ float rowpos(int row) { return (float)(row < TP ? (row & 4095) : 16384 + ((row - TP) & 7)); }

namespace pg8 {
constexpr int BM = 256, BK = 64, HALF = 128, HTB = HALF * BK * 2, STAGE_BYTES = 8 * HTB, NXCD = 8, WGM = 8;
__device__ __forceinline__ int lds_byte(int r, int c) { const int st = (r >> 4) * 2 + (c >> 5), rr = r & 15, cc = c & 31, ob = rr * 64 + cc * 2; return st * 1024 + (ob ^ (((ob >> 9) & 1) << 5)); }
__device__ __forceinline__ void stage_rc(int b, int& R, int& C) { const int st = b / 1024, sb = b % 1024, swz = sb ^ (((sb >> 9) & 1) << 5); R = (st >> 1) * 16 + swz / 64; C = (st & 1) * 32 + (swz % 64) / 2; }
struct Unit { const char* A; const char* B; int pm, pn, kind; };

struct Sched {
    int nM, nN, nwg, G, c; const char* A; const char* B; size_t tstep;
    int xn, xnM; const char* xA; const char* xB;
    __device__ void init(const void* A_, const void* B_, int M, int N, int K, int G_, int c_) { nM = M / BM; nN = N / BM; nwg = nM * nN; G = G_; c = c_; A = (const char*)A_; B = (const char*)B_; tstep = (size_t)BM * K * 2; xn = 0; xnM = 1; xA = nullptr; xB = nullptr; }
    __device__ void extra(const void* A_, const void* B_, int M, int N) { xnM = M / BM; xn = xnM * (N / BM); xA = (const char*)A_; xB = (const char*)B_; }
    __device__ bool next(int i, Unit& u) const {
        const long L = (long)i * G + c;
        if (L < nwg) {
            int wgid = (int)L; { const int q = nwg / NXCD, r = nwg % NXCD, xcd = wgid % NXCD, off = wgid / NXCD; wgid = (xcd < r ? xcd * (q + 1) : r * (q + 1) + (xcd - r) * q) + off; }
            const int nig = WGM * nN, gid = wgid / nig, fm = gid * WGM, gsz = (nM - fm) < WGM ? (nM - fm) : WGM;
            u.pm = fm + ((wgid % nig) % gsz); u.pn = (wgid % nig) / gsz; u.kind = 0;
            u.A = A + (size_t)u.pm * tstep; u.B = B + (size_t)u.pn * tstep; return true;
        }
        const int X = (int)(L - nwg);
        if (X < xn) { u.pm = X % xnM; u.pn = X / xnM; u.kind = 1; u.A = xA + (size_t)u.pm * tstep; u.B = xB + (size_t)u.pn * tstep; return true; }
        return false;
    }
};

template <class Epi, class SchedT = Sched>
__device__ __forceinline__ void gemm_phase(LAS unsigned char* lds, const int K, const SchedT& S, const Epi& E) {
    const int tid = threadIdx.x, wid = __builtin_amdgcn_readfirstlane(tid >> 6), lane = tid & 63, wr = wid >> 2, wc = wid & 3, fr = lane & 15, fq = lane >> 4;
    const int nt = K / BK;
    unsigned voffA[2];
#pragma unroll
    for (int i = 0; i < 2; ++i) { int R, C; stage_rc(tid * 16 + i * 8192, R, C); voffA[i] = (unsigned)(R * K + C) * 2u; }
    const size_t kstep = (size_t)(BK * 2);
    const size_t hstep = (size_t)HALF * K * 2;
    const unsigned ldsw = (unsigned)wid * 1024u;
    const int aoff = lds_byte(wr * 64 + fr, fq * 8), boff = lds_byte(wc * 32 + fr, fq * 8);
#define PG8_SA(b, h) (((b) * 2 + (h)) * HTB)
#define PG8_SB(b, h) ((4 + (b) * 2 + (h)) * HTB)
#define PG8_STAGE(bufoff, gbase) do { _Pragma("unroll") for (int _i = 0; _i < 2; ++_i) \
        __builtin_amdgcn_global_load_lds((const unsigned*)((const char*)(gbase) + voffA[_i]), (LAS unsigned*)(lds + (bufoff) + ldsw + _i * 8192), 16, 0, 0); } while (0)
#define PG8_LDA(dst, b, h) do { _Pragma("unroll") for (int m = 0; m < 4; ++m) _Pragma("unroll") for (int k = 0; k < 2; ++k) dst[m][k] = *(const LAS bf16x8*)(lds + PG8_SA(b, h) + aoff + m * 2048 + k * 1024); } while (0)
#define PG8_LDB(dst, b, h) do { _Pragma("unroll") for (int n = 0; n < 2; ++n) _Pragma("unroll") for (int k = 0; k < 2; ++k) dst[n][k] = *(const LAS bf16x8*)(lds + PG8_SB(b, h) + boff + n * 2048 + k * 1024); } while (0)
#define PG8_MMA(ai, bj, At, Bt) do { __builtin_amdgcn_s_setprio(1); _Pragma("unroll") for (int m = 0; m < 4; ++m) _Pragma("unroll") for (int n = 0; n < 2; ++n) _Pragma("unroll") for (int k = 0; k < 2; ++k) \
        acc[ai][bj][m][n] = __builtin_amdgcn_mfma_f32_16x16x32_bf16(Bt[n][k], At[m][k], acc[ai][bj][m][n], 0, 0, 0); __builtin_amdgcn_s_setprio(0); } while (0)
#define PG8_WAIT_V(n) asm volatile("s_waitcnt vmcnt(" #n ")" ::: "memory")
#define PG8_WAIT_L(n) asm volatile("s_waitcnt lgkmcnt(" #n ")" ::: "memory")
#define PG8_BAR __builtin_amdgcn_s_barrier()
#define PG8_SCHED __builtin_amdgcn_sched_barrier(0)
    Unit cur, nxt; int ui = 0;
    if (!S.next(0, cur)) return;
    f32x4 acc[2][2][4][2];
#pragma unroll
    for (int a = 0; a < 2; ++a)
#pragma unroll
        for (int b = 0; b < 2; ++b)
#pragma unroll
            for (int m = 0; m < 4; ++m)
#pragma unroll
                for (int n = 0; n < 2; ++n) acc[a][b][m][n] = (f32x4){0.f, 0.f, 0.f, 0.f};
    bf16x8 At[4][2], B0[2][2], B1[2][2];
    const char* cA = cur.A; const char* cB = cur.B;
    PG8_STAGE(PG8_SB(0, 0), cB); PG8_STAGE(PG8_SA(0, 0), cA); PG8_STAGE(PG8_SB(0, 1), cB + hstep); PG8_STAGE(PG8_SA(0, 1), cA + hstep);
    if (wr == 1) PG8_BAR;
    PG8_WAIT_V(4); PG8_BAR;
    PG8_STAGE(PG8_SB(1, 0), cB + kstep); PG8_STAGE(PG8_SA(1, 0), cA + kstep); PG8_STAGE(PG8_SB(1, 1), cB + hstep + kstep);
    PG8_WAIT_V(6); PG8_BAR;
    for (;;) {
        const bool has_next = S.next(ui + 1, nxt);
        const char* nA = has_next ? nxt.A : cA; const char* nB = has_next ? nxt.B : cB;
        for (int t = 0; t < nt; t += 2) {
            const bool last = (t == nt - 2);
            const char* a1 = cA + (size_t)(t + 1) * kstep;
            const char* a2 = last ? nA : cA + (size_t)(t + 2) * kstep; const char* b2 = last ? nB : cB + (size_t)(t + 2) * kstep;
            const char* a3 = a2 + kstep; const char* b3 = b2 + kstep;
            PG8_LDB(B0, 0, 0); PG8_SCHED; PG8_LDA(At, 0, 0); PG8_STAGE(PG8_SA(1, 1), a1 + hstep);
            PG8_WAIT_L(8); PG8_BAR; PG8_WAIT_L(0); PG8_MMA(0, 0, At, B0); PG8_BAR; PG8_SCHED;
            PG8_LDB(B1, 0, 1); PG8_STAGE(PG8_SB(0, 0), b2);
            PG8_BAR; PG8_WAIT_L(0); PG8_MMA(0, 1, At, B1); PG8_BAR;
            PG8_LDA(At, 0, 1); PG8_STAGE(PG8_SA(0, 0), a2);
            PG8_BAR; PG8_WAIT_L(0); PG8_MMA(1, 0, At, B0); PG8_BAR; PG8_SCHED;
            PG8_STAGE(PG8_SB(0, 1), b2 + hstep);
            PG8_WAIT_V(6); PG8_BAR; PG8_MMA(1, 1, At, B1); PG8_BAR;
            PG8_LDB(B0, 1, 0); PG8_SCHED; PG8_LDA(At, 1, 0); PG8_STAGE(PG8_SA(0, 1), a2 + hstep);
            PG8_WAIT_L(8); PG8_BAR; PG8_WAIT_L(0); PG8_MMA(0, 0, At, B0); PG8_BAR; PG8_SCHED;
            PG8_LDB(B1, 1, 1); PG8_STAGE(PG8_SB(1, 0), b3);
            PG8_BAR; PG8_WAIT_L(0); PG8_MMA(0, 1, At, B1); PG8_BAR;
            PG8_LDA(At, 1, 1); PG8_STAGE(PG8_SA(1, 0), a3);
            PG8_BAR; PG8_WAIT_L(0); PG8_MMA(1, 0, At, B0); PG8_BAR; PG8_SCHED;
            PG8_STAGE(PG8_SB(1, 1), b3 + hstep);
            PG8_WAIT_V(6); PG8_BAR; PG8_MMA(1, 1, At, B1); PG8_BAR;
        }
        E(acc, cur, wr, wc, fr, fq);
        if (!has_next) break;
#pragma unroll
        for (int a = 0; a < 2; ++a)
#pragma unroll
            for (int b = 0; b < 2; ++b)
#pragma unroll
                for (int m = 0; m < 4; ++m)
#pragma unroll
                    for (int n = 0; n < 2; ++n) acc[a][b][m][n] = (f32x4){0.f, 0.f, 0.f, 0.f};
        cur = nxt; cA = nA; cB = nB; ++ui;
    }
    PG8_WAIT_V(0);
    if (wr == 0) PG8_BAR;
    PG8_BAR;
#undef PG8_SA
#undef PG8_SB
#undef PG8_STAGE
#undef PG8_LDA
#undef PG8_LDB
#undef PG8_MMA
#undef PG8_WAIT_V
#undef PG8_WAIT_L
#undef PG8_BAR
#undef PG8_SCHED
}
}
using pg8::Unit;


struct EpiA {
    unsigned char* ws; const float* gq; const float* gk; float* out;
    __device__ __forceinline__ void operator()(const f32x4 (&acc)[2][2][4][2], const Unit& u, int wr, int wc, int fr, int fq) const {
        const int pn = u.pn;
        const float* rstd0 = (const float*)(ws + WS_RSTD0); const float* rstdm = (const float*)(ws + WS_RSTDM);
        const float* cosA = (const float*)(ws + WS_ROPE); const float* sinA = (const float*)(ws + WS_ROPE + ROPE_T); const float* cosR = (const float*)(ws + WS_ROPE + 2 * ROPE_T); const float* sinR = (const float*)(ws + WS_ROPE + 3 * ROPE_T);
        float rsv[8];
#pragma unroll
        for (int it = 0; it < 8; ++it) { const int r_ = u.pm * 256 + (it >> 2) * 128 + wr * 64 + (it & 3) * 16 + fr; rsv[it] = (u.kind == 0) ? rstd0[r_] : rstdm[r_]; }
        bf16_t* qa = (bf16_t*)(ws + WS_QA); bf16_t* ka = (bf16_t*)(ws + WS_KA); bf16_t* va = (bf16_t*)(ws + WS_VA); bf16_t* qr = (bf16_t*)(ws + WS_QR); bf16_t* kr = (bf16_t*)(ws + WS_KR); bf16_t* vr = (bf16_t*)(ws + WS_VR); bf16_t* gs = (bf16_t*)(ws + WS_GS); bf16_t* mvb = (bf16_t*)(ws + WS_MVB);
        if (u.kind == 0) {
            if (pn < 2 || (pn == 2 && wc < 2)) {
                const bool isq = pn < 2;
                const float* gp = isq ? gq : gk;
                const float osc = isq ? 0.125f * LOG2E : 1.0f;
#pragma unroll
                for (int ai = 0; ai < 2; ++ai)
#pragma unroll
                    for (int m = 0; m < 4; ++m) {
                        const int row = u.pm * 256 + ai * 128 + wr * 64 + m * 16 + fr;
                        const float rs = rsv[ai * 4 + m];
                        f32x4 v00 = acc[ai][0][m][0] * rs, v01 = acc[ai][0][m][1] * rs, v10 = acc[ai][1][m][0] * rs, v11 = acc[ai][1][m][1] * rs;
                        float ss = (dot4(v00) + dot4(v01)) + (dot4(v10) + dot4(v11));
                        ss += __shfl_xor(ss, 16); ss += __shfl_xor(ss, 32);
                        const float rn = __builtin_amdgcn_rsqf(ss * (1.0f / 64.0f) + EPS);
                        v00 = v00 * rn * *(const f32x4*)(gp + 8 * fq); v01 = v01 * rn * *(const f32x4*)(gp + 8 * fq + 4); v10 = v10 * rn * *(const f32x4*)(gp + 32 + 8 * fq); v11 = v11 * rn * *(const f32x4*)(gp + 36 + 8 * fq);
                        const float posf = rowpos(row);
                        int fqv = fq; asm volatile("" : "+v"(fqv));
                        f32x4 c0, c1, s0, s1;
#pragma unroll
                        for (int j = 0; j < 4; ++j) { const float a0 = __builtin_amdgcn_fractf(posf * (ex2((float)(8 * fqv + j) * (-13.287712379549449f / 32.0f)) * 0.15915494309189535f)), a1 = __builtin_amdgcn_fractf(posf * (ex2((float)(8 * fqv + 4 + j) * (-13.287712379549449f / 32.0f)) * 0.15915494309189535f));
                            c0[j] = __builtin_amdgcn_cosf(a0); s0[j] = __builtin_amdgcn_sinf(a0); c1[j] = __builtin_amdgcn_cosf(a1); s1[j] = __builtin_amdgcn_sinf(a1); }
                        const f32x4 o00 = (v00 * c0 - v10 * s0) * osc, o10 = (v10 * c0 + v00 * s0) * osc, o01 = (v01 * c1 - v11 * s1) * osc, o11 = (v11 * c1 + v01 * s1) * osc;
                        if (isq) {
                            bf16_t* d = qa + (size_t)row * 512 + (pn * 4 + wc) * 64 + 8 * fq;
                            *(u32x4*)d = pack8(o00, o01); *(u32x4*)(d + 32) = pack8(o10, o11);
                        } else {
                            bf16_t* d = ka + (size_t)row * 128 + wc * 64 + 8 * fq;
                            *(u32x4*)d = pack8(o00, o01); *(u32x4*)(d + 32) = pack8(o10, o11);
                            float* fo = nullptr;
                            if (u.pm >= 128) { const int r = row - TP; fo = out + O_SWAKS + ((size_t)((r >> 3) * 128 + 120 + (r & 7)) * 2 + wc) * 64; }
                            else if ((u.pm & 15) == 15 && ai == 1) { fo = out + O_SWAKP + ((size_t)((row >> 12) * 128 + ((row & 4095) - 3968)) * 2 + wc) * 64; }
                            if (fo) { fo += 8 * fq; *(f32x4*)fo = o00; *(f32x4*)(fo + 4) = o01; *(f32x4*)(fo + 32) = o10; *(f32x4*)(fo + 36) = o11; }
                        }
                    }
            } else if (pn == 2) {
                const int kvh = wc - 2;
#pragma unroll
                for (int ai = 0; ai < 2; ++ai)
#pragma unroll
                    for (int m = 0; m < 4; ++m) {
                        const int row = u.pm * 256 + ai * 128 + wr * 64 + m * 16 + fr;
                        const float rs = rsv[ai * 4 + m];
                        const f32x4 v00 = acc[ai][0][m][0] * rs, v01 = acc[ai][0][m][1] * rs, v10 = acc[ai][1][m][0] * rs, v11 = acc[ai][1][m][1] * rs;
                        bf16_t* d = va + (size_t)row * 128 + kvh * 64 + 8 * fq;
                        *(u32x4*)d = pack8(v00, v01); *(u32x4*)(d + 32) = pack8(v10, v11);
                        float* fo = nullptr;
                        if (u.pm >= 128) { const int r = row - TP; fo = out + O_SWAVS + ((size_t)((r >> 3) * 128 + 120 + (r & 7)) * 2 + kvh) * 64; }
                        else if ((u.pm & 15) == 15 && ai == 1) { fo = out + O_SWAVP + ((size_t)((row >> 12) * 128 + ((row & 4095) - 3968)) * 2 + kvh) * 64; }
                        if (fo) { fo += 8 * fq; *(f32x4*)fo = v00; *(f32x4*)(fo + 4) = v01; *(f32x4*)(fo + 32) = v10; *(f32x4*)(fo + 36) = v11; }
                    }
            } else if (pn <= 6) {
                const bool isq = pn <= 4;
                bf16_t* base = isq ? qr : kr;
                const int head = ((pn - 3) & 1) * 4 + wc;
                const float osc = isq ? 1.0f : 0.125f;
#pragma unroll
                for (int ai = 0; ai < 2; ++ai)
#pragma unroll
                    for (int m = 0; m < 4; ++m) {
                        const int row = u.pm * 256 + ai * 128 + wr * 64 + m * 16 + fr;
                        const float rs = rsv[ai * 4 + m] * osc;
                        const float posf = rowpos(row);
                        int fqv = fq; asm volatile("" : "+v"(fqv));
                        f32x4 o[2][2];
#pragma unroll
                        for (int bj = 0; bj < 2; ++bj)
#pragma unroll
                            for (int n = 0; n < 2; ++n) {
                                const f32x4 v = acc[ai][bj][m][n] * rs;
                                const float a0 = __builtin_amdgcn_fractf(posf * (ex2((float)(16 * bj + 4 * fqv + 2 * n) * (-13.287712379549449f / 31.0f)) * 0.15915494309189535f)), a1 = __builtin_amdgcn_fractf(posf * (ex2((float)(16 * bj + 4 * fqv + 2 * n + 1) * (-13.287712379549449f / 31.0f)) * 0.15915494309189535f));
                                const f32x2 c = {__builtin_amdgcn_cosf(a0), __builtin_amdgcn_cosf(a1)}, s = {__builtin_amdgcn_sinf(a0), __builtin_amdgcn_sinf(a1)};
                                o[bj][n] = (f32x4){v[0] * c[0] - v[1] * s[0], v[1] * c[0] + v[0] * s[0], v[2] * c[1] - v[3] * s[1], v[3] * c[1] + v[2] * s[1]};
                            }
                        bf16_t* d = base + (size_t)row * 512 + head * 64 + 8 * fq;
                        *(u32x4*)d = pack8(o[0][0], o[0][1]); *(u32x4*)(d + 32) = pack8(o[1][0], o[1][1]);
                    }
            } else {
                const bool isg = pn >= 9;
                bf16_t* base = isg ? gs : vr;
                const int head = ((pn - 7) & 1) * 4 + wc;
#pragma unroll
                for (int ai = 0; ai < 2; ++ai)
#pragma unroll
                    for (int m = 0; m < 4; ++m) {
                        const int row = u.pm * 256 + ai * 128 + wr * 64 + m * 16 + fr;
                        const float rs = rsv[ai * 4 + m];
                        f32x4 o[2][2];
#pragma unroll
                        for (int bj = 0; bj < 2; ++bj)
#pragma unroll
                            for (int n = 0; n < 2; ++n) {
                                f32x4 v = acc[ai][bj][m][n] * rs;
                                if (isg) { v[0] = silu(v[0]); v[1] = silu(v[1]); v[2] = silu(v[2]); v[3] = silu(v[3]); }
                                o[bj][n] = v;
                            }
                        bf16_t* d = base + (size_t)row * 512 + head * 64 + 8 * fq;
                        *(u32x4*)d = pack8(o[0][0], o[0][1]); *(u32x4*)(d + 32) = pack8(o[1][0], o[1][1]);
                    }
            }
        } else {
            const bool isk = pn < 2;
            const int cb = (pn & 1) * 256 + wc * 64 + 8 * fq;
#pragma unroll
            for (int ai = 0; ai < 2; ++ai)
#pragma unroll
                for (int m = 0; m < 4; ++m) {
                    const int row = u.pm * 256 + ai * 128 + wr * 64 + m * 16 + fr;
                    const float rs = rsv[ai * 4 + m];
                    const f32x4 v00 = acc[ai][0][m][0] * rs, v01 = acc[ai][0][m][1] * rs, v10 = acc[ai][1][m][0] * rs, v11 = acc[ai][1][m][1] * rs;
                    float* fo = out + (isk ? O_MEMKP : O_MEMVP) + (size_t)row * 512 + cb;
                    *(f32x4*)fo = v00; *(f32x4*)(fo + 4) = v01; *(f32x4*)(fo + 32) = v10; *(f32x4*)(fo + 36) = v11;
                    if (!isk) { bf16_t* d = mvb + (size_t)row * 512 + cb; *(u32x4*)d = pack8(v00, v01); *(u32x4*)(d + 32) = pack8(v10, v11); }
                }
        }
    }
};

template <int MODE>
struct EpiRes {
    const float* xp; const float* xs; float* out; bf16_t* xb; float* ssq;
    __device__ __forceinline__ void operator()(const f32x4 (&acc)[2][2][4][2], const Unit& u, int wr, int wc, int fr, int fq) const {
        const int cb = u.pn * 256 + wc * 64 + 8 * fq;
        const int row0 = u.pm * 256 + wr * 64 + fr;
        if (MODE == 0) {
            const float* base = (u.pm < 128 ? xp + (size_t)row0 * 1024 : xs + (size_t)(row0 - TP) * 1024) + cb;
            f32x4 nb[4];
            nb[0] = *(const f32x4*)base; nb[1] = *(const f32x4*)(base + 4); nb[2] = *(const f32x4*)(base + 32); nb[3] = *(const f32x4*)(base + 36);
#pragma unroll
            for (int it = 0; it < 8; ++it) {
                const int ai = it >> 2, m = it & 3;
                const int row = row0 + ai * 128 + m * 16;
                const f32x4 r00 = nb[0] + acc[ai][0][m][0], r01 = nb[1] + acc[ai][0][m][1], r10 = nb[2] + acc[ai][1][m][0], r11 = nb[3] + acc[ai][1][m][1];
                if (it < 7) { const float* bp = base + (size_t)(((it + 1) >> 2) * 128 + ((it + 1) & 3) * 16) * 1024;
                    nb[0] = *(const f32x4*)bp; nb[1] = *(const f32x4*)(bp + 4); nb[2] = *(const f32x4*)(bp + 32); nb[3] = *(const f32x4*)(bp + 36); }
                bf16_t* d = xb + (size_t)row * 1024 + cb;
                *(u32x4*)d = pack8(r00, r01); *(u32x4*)(d + 32) = pack8(r10, r11);
                float ss = (dot4(r00) + dot4(r01)) + (dot4(r10) + dot4(r11));
                ss += __shfl_xor(ss, 16); ss += __shfl_xor(ss, 32);
                if (fq == 0) ssq[(size_t)(u.pn * 4 + wc) * TT + row] = ss;
            }
        } else {
            u32x4 b[8][2];
#pragma unroll
            for (int it = 0; it < 4; ++it) { const bf16_t* bp = xb + (size_t)(row0 + (it >> 2) * 128 + (it & 3) * 16) * 1024 + cb; b[it][0] = *(const u32x4*)bp; b[it][1] = *(const u32x4*)(bp + 32); }
#pragma unroll
            for (int it = 0; it < 8; ++it) {
                const int ai = it >> 2, m = it & 3;
                const int row = row0 + ai * 128 + m * 16;
                const u32x4 w0 = b[it][0], w1 = b[it][1];
                if (it < 4) { const bf16_t* bp = xb + (size_t)(row0 + 128 + it * 16) * 1024 + cb; b[it + 4][0] = *(const u32x4*)bp; b[it + 4][1] = *(const u32x4*)(bp + 32); }
                const f32x4 r00 = (f32x4){bflo(w0.x), bfhi(w0.x), bflo(w0.y), bfhi(w0.y)} + acc[ai][0][m][0], r01 = (f32x4){bflo(w0.z), bfhi(w0.z), bflo(w0.w), bfhi(w0.w)} + acc[ai][0][m][1];
                const f32x4 r10 = (f32x4){bflo(w1.x), bfhi(w1.x), bflo(w1.y), bfhi(w1.y)} + acc[ai][1][m][0], r11 = (f32x4){bflo(w1.z), bfhi(w1.z), bflo(w1.w), bfhi(w1.w)} + acc[ai][1][m][1];
                if (MODE == 1) {
                    bf16_t* d = xb + (size_t)row * 1024 + cb;
                    *(u32x4*)d = pack8(r00, r01); *(u32x4*)(d + 32) = pack8(r10, r11);
                    float ss = (dot4(r00) + dot4(r01)) + (dot4(r10) + dot4(r11));
                    ss += __shfl_xor(ss, 16); ss += __shfl_xor(ss, 32);
                    if (fq == 0) ssq[(size_t)(u.pn * 4 + wc) * TT + row] = ss;
                } else {
                    float* op = out + (size_t)row * 1024 + cb;
                    __builtin_nontemporal_store(r00, (f32x4*)op); __builtin_nontemporal_store(r01, (f32x4*)(op + 4)); __builtin_nontemporal_store(r10, (f32x4*)(op + 32)); __builtin_nontemporal_store(r11, (f32x4*)(op + 36));
                }
            }
        }
    }
};

__device__ __forceinline__ float row_rstd16(const float* ssq, int row, int fq) {
    const float* pp = ssq + (size_t)(4 * fq) * TT + row;
    float s = (pp[0] + pp[TT]) + (pp[2 * (size_t)TT] + pp[3 * (size_t)TT]);
    s += __shfl_xor(s, 16); s += __shfl_xor(s, 32);
    return __builtin_amdgcn_rsqf(s * (1.0f / 1024.0f) + EPS);
}

struct EpiMq {
    const float* ssq1; bf16_t* qm; float* ssqm;
    __device__ __forceinline__ void operator()(const f32x4 (&acc)[2][2][4][2], const Unit& u, int wr, int wc, int fr, int fq) const {
        const int cb = u.pn * 256 + wc * 64 + 8 * fq;
        float rsv[8];
#pragma unroll
        for (int it = 0; it < 8; ++it) rsv[it] = row_rstd16(ssq1, u.pm * 256 + (it >> 2) * 128 + wr * 64 + (it & 3) * 16 + fr, fq);
#pragma unroll
        for (int ai = 0; ai < 2; ++ai)
#pragma unroll
            for (int m = 0; m < 4; ++m) {
                const int row = u.pm * 256 + ai * 128 + wr * 64 + m * 16 + fr;
                const float rs = rsv[ai * 4 + m];
                const f32x4 v00 = acc[ai][0][m][0] * rs, v01 = acc[ai][0][m][1] * rs, v10 = acc[ai][1][m][0] * rs, v11 = acc[ai][1][m][1] * rs;
                bf16_t* d = qm + (size_t)row * 512 + cb;
                *(u32x4*)d = pack8(v00, v01); *(u32x4*)(d + 32) = pack8(v10, v11);
                float ss = (dot4(v00) + dot4(v01)) + (dot4(v10) + dot4(v11));
                ss += __shfl_xor(ss, 16); ss += __shfl_xor(ss, 32);
                if (fq == 0) ssqm[(size_t)(u.pn * 4 + wc) * TT + row] = ss;
            }
    }
};

struct EpiGu {
    const float* ssq2; bf16_t* hid; unsigned* ready;
    __device__ __forceinline__ void operator()(const f32x4 (&acc)[2][2][4][2], const Unit& u, int wr, int wc, int fr, int fq) const {
        const int cb = u.pn * 128 + wc * 32 + 8 * fq;
        float rsv[8];
#pragma unroll
        for (int it = 0; it < 8; ++it) rsv[it] = row_rstd16(ssq2, u.pm * 256 + (it >> 2) * 128 + wr * 64 + (it & 3) * 16 + fr, fq);
#pragma unroll
        for (int ai = 0; ai < 2; ++ai)
#pragma unroll
            for (int m = 0; m < 4; ++m) {
                const int row = u.pm * 256 + ai * 128 + wr * 64 + m * 16 + fr;
                const float rs = rsv[ai * 4 + m];
                f32x4 h[2];
#pragma unroll
                for (int n = 0; n < 2; ++n) {
                    const f32x4 g = acc[ai][0][m][n] * rs, uu = acc[ai][1][m][n] * rs;
                    h[n] = (f32x4){silu(g[0]) * uu[0], silu(g[1]) * uu[1], silu(g[2]) * uu[2], silu(g[3]) * uu[3]};
                }
                *(u32x4*)(hid + (size_t)row * 2816 + cb) = pack8(h[0], h[1]);
            }
        if (u.pm >= 128) {
            asm volatile("s_waitcnt vmcnt(0)" ::: "memory");
            __builtin_amdgcn_fence(__ATOMIC_RELEASE, "agent");
            asm volatile("s_waitcnt vmcnt(0)" ::: "memory");
            if ((threadIdx.x & 63) == 0) (void)__hip_atomic_fetch_add(ready, 1u, __ATOMIC_RELAXED, __HIP_MEMORY_SCOPE_AGENT);
        }
    }
};
struct SchedOne {
    const char* A; const char* B; int pm, pn; bool on;
    __device__ bool next(int i, Unit& u) const { if (i > 0 || !on) return false; u.pm = pm; u.pn = pn; u.kind = 0; u.A = A; u.B = B; return true; }
};
struct SchedGu {
    pg8::Sched P; int G, c; const char* A; const char* B;
    __device__ bool next(int i, Unit& u) const {
        long L;
        if (G == 256) {
            if (c < 240) { L = (long)i * 240 + c; if (L >= 2760) return false; }
            else { if (i >= 9) return false; L = 2760 + (long)(c - 240) * 9 + i; }
        } else L = (long)i * G + c;
        if (L < 88) { u.pm = 128 + (int)(L & 3); u.pn = (int)(L >> 2); u.kind = 0; u.A = A + (size_t)u.pm * 256 * 1024 * 2; u.B = B + (size_t)u.pn * 256 * 1024 * 2; return true; }
        const long Lp = L - 88;
        if (Lp >= P.nwg) return false;
        pg8::Sched Q = P; Q.G = 1; Q.c = 0;
        return Q.next((int)Lp, u);
    }
};
struct SchedDnTail {
    const char* A; const char* B; int u0;
    __device__ bool next(int i, Unit& u) const {
        if (i > 0 || u0 < 0 || u0 >= 16) return false;
        u.pm = 128 + (u0 & 3); u.pn = u0 >> 2; u.kind = 0;
        u.A = A + (size_t)u.pm * 256 * 2816 * 2; u.B = B + (size_t)u.pn * 256 * 2816 * 2; return true;
    }
};

__device__ __forceinline__ int srccol(int p, int mode) {
    const int tile = p >> 8, q = p & 255, bj = q >> 7, wc = (q >> 5) & 3, n = (q >> 4) & 1, fq = (q >> 2) & 3, j = q & 3;
    if (mode == 0) return tile * 256 + 64 * wc + 32 * bj + 8 * fq + 4 * n + j;
    return bj * 2816 + 128 * tile + 32 * wc + 8 * fq + 4 * n + j;
}
__device__ __forceinline__ void conv_w(const float* __restrict__ W, bf16_t* __restrict__ Wt, const float* __restrict__ gain, int K, int N, int mode, int gtid, int gsz) {
    const int n4 = N >> 2, n48 = n4 >> 3, total = n4 * (K >> 3);
    for (int it = gtid; it < total; it += gsz) {
        const int rest = it >> 6, pg = (rest % n48) * 8 + ((it >> 3) & 7), kc = (rest / n48) * 8 + (it & 7);
        const int p0 = pg * 4, k0 = kc * 8; const int src = srccol(p0, mode);
        f32x4 v[8];
#pragma unroll
        for (int j = 0; j < 8; ++j) { v[j] = __builtin_nontemporal_load((const f32x4*)(W + (size_t)(k0 + j) * N + src)); if (gain) v[j] = v[j] * gain[k0 + j]; }
#pragma unroll
        for (int i = 0; i < 4; ++i) {
            u32x4 o; o.x = pk2(v[0][i], v[1][i]); o.y = pk2(v[2][i], v[3][i]); o.z = pk2(v[4][i], v[5][i]); o.w = pk2(v[6][i], v[7][i]);
            *(u32x4*)(Wt + (size_t)(p0 + i) * K + k0) = o;
        }
    }
}
__device__ __forceinline__ void phase0(const Params& P) {
    unsigned char* ws = P.ws;
    const int tid = threadIdx.x, lane = tid & 63, wave = tid >> 6;
    const int gtid = blockIdx.x * NTHR + tid, gsz = gridDim.x * NTHR;
    for (int row0 = (blockIdx.x * 8 + wave) * 8; row0 < TT + 2048; row0 += gridDim.x * 64) {
        const float* src[8]; bf16_t* dst[8]; float* rs[8];
#pragma unroll
        for (int r = 0; r < 8; ++r) {
            const int row = row0 + r;
            if (row < TP) { src[r] = P.in[0] + (size_t)row * 1024; dst[r] = (bf16_t*)(ws + WS_XB) + (size_t)row * 1024; rs[r] = (float*)(ws + WS_RSTD0) + row; }
            else if (row < TT) { src[r] = P.in[1] + (size_t)(row - TP) * 1024; dst[r] = (bf16_t*)(ws + WS_XB) + (size_t)row * 1024; rs[r] = (float*)(ws + WS_RSTD0) + row; }
            else { src[r] = P.in[2] + (size_t)(row - TT) * 1024; dst[r] = (bf16_t*)(ws + WS_MEMB) + (size_t)(row - TT) * 1024; rs[r] = (float*)(ws + WS_RSTDM) + (row - TT); }
        }
        f32x4 v[8][4]; float ss[8] = {0.f, 0.f, 0.f, 0.f, 0.f, 0.f, 0.f, 0.f};
#pragma unroll
        for (int r = 0; r < 8; ++r)
#pragma unroll
            for (int i = 0; i < 4; ++i) v[r][i] = __builtin_nontemporal_load((const f32x4*)(src[r] + 4 * (lane + 64 * i)));
#pragma unroll
        for (int r = 0; r < 8; ++r) {
#pragma unroll
            for (int i = 0; i < 4; ++i) ss[r] += dot4(v[r][i]);
#pragma unroll
            for (int o = 1; o < 64; o <<= 1) ss[r] += __shfl_xor(ss[r], o);
            if (lane == 0) *rs[r] = __builtin_amdgcn_rsqf(ss[r] * (1.0f / 1024.0f) + EPS);
#pragma unroll
            for (int i = 0; i < 4; ++i) { u32x2 w; w.x = pk2(v[r][i][0], v[r][i][1]); w.y = pk2(v[r][i][2], v[r][i][3]); *(u32x2*)(dst[r] + 4 * (lane + 64 * i)) = w; }
        }
    }
    conv_w(P.in[9], (bf16_t*)(ws + WS_WIN), P.in[8], 1024, 2816, 0, gtid, gsz);
    conv_w(P.in[13], (bf16_t*)(ws + WS_WOUT), nullptr, 1024, 1024, 0, gtid, gsz);
    conv_w(P.in[16], (bf16_t*)(ws + WS_WMQ), P.in[14], 1024, 512, 0, gtid, gsz);
    conv_w(P.in[17], (bf16_t*)(ws + WS_WMKV), P.in[15], 1024, 1024, 0, gtid, gsz);
    conv_w(P.in[20], (bf16_t*)(ws + WS_WMO), nullptr, 512, 1024, 0, gtid, gsz);
    conv_w(P.in[22], (bf16_t*)(ws + WS_WGU), P.in[21], 1024, 5632, 1, gtid, gsz);
    conv_w(P.in[23], (bf16_t*)(ws + WS_WDN), nullptr, 2816, 1024, 0, gtid, gsz);
}

constexpr int KS64 = 144;
constexpr int KS128 = 272;

__device__ __forceinline__ void swa_qblock(LAS const unsigned char* Kl, LAS const unsigned char* Vl, int kb_lo, const bf16_t* qptr, bf16_t* optr, bool do_store,
                                           int qi, int jmin, float sink2, int lane) {
    const int fr = lane & 15, fq = lane >> 4;
    bf16x8 qf[2]; qf[0] = *(const bf16x8*)(qptr + 8 * fq); qf[1] = *(const bf16x8*)(qptr + 32 + 8 * fq);
    f32x4 s[10];
    LAS const unsigned char* kbase = Kl + (kb_lo * 16 + fr) * KS64 + fq * 16;
#pragma unroll
    for (int i = 0; i < 10; ++i) {
        f32x4 a = {0.f, 0.f, 0.f, 0.f};
#pragma unroll
        for (int ks = 0; ks < 2; ++ks) { const bf16x8 kf = *(LAS const bf16x8*)(kbase + i * 16 * KS64 + ks * 64); a = __builtin_amdgcn_mfma_f32_16x16x32_bf16(kf, qf[ks], a, 0, 0, 0); }
        s[i] = a;
        if (i & 1) __builtin_amdgcn_sched_barrier(0);
    }
    float mx = sink2;
    const int jb = kb_lo * 16 + 4 * fq;
#pragma unroll
    for (int i = 0; i < 10; ++i)
#pragma unroll
        for (int e = 0; e < 4; ++e) { const int j = jb + 16 * i + e; const bool ok = (j > qi) && (j <= qi + 128) && (j >= jmin); const float v = ok ? s[i][e] : -1e30f; s[i][e] = v; mx = fmaxf(mx, v); }
    mx = fmaxf(mx, __shfl_xor(mx, 16)); mx = fmaxf(mx, __shfl_xor(mx, 32));
    float sum = 0.f;
#pragma unroll
    for (int i = 0; i < 10; ++i)
#pragma unroll
        for (int e = 0; e < 4; ++e) { const float p = ex2(s[i][e] - mx); s[i][e] = p; sum += p; }
    sum += __shfl_xor(sum, 16); sum += __shfl_xor(sum, 32);
    sum += ex2(sink2 - mx);
    const float inv = __builtin_amdgcn_rcpf(sum);
    f32x4 o[4];
#pragma unroll
    for (int d = 0; d < 4; ++d) o[d] = (f32x4){0.f, 0.f, 0.f, 0.f};
    LAS const unsigned char* vbase = Vl + (kb_lo * 16 + 4 * fq + (fr >> 2)) * KS64 + (fr & 3) * 8;
#pragma unroll
    for (int g = 0; g < 5; ++g) {
        const bf16x8 pf = as_bf16x8(pack8(s[2 * g] * inv, s[2 * g + 1] * inv));
#pragma unroll
        for (int db = 0; db < 4; ++db) {
            const bf16x4 v0 = trread(vbase + (2 * g) * 16 * KS64 + db * 32), v1 = trread(vbase + (2 * g + 1) * 16 * KS64 + db * 32);
            o[db] = __builtin_amdgcn_mfma_f32_16x16x32_bf16(cat4(v0, v1), pf, o[db], 0, 0, 0);
        }
        __builtin_amdgcn_sched_barrier(0);
    }
    if (do_store) {
#pragma unroll
        for (int db = 0; db < 4; ++db) { u32x2 w; w.x = pk2(o[db][0], o[db][1]); w.y = pk2(o[db][2], o[db][3]); *(u32x2*)(optr + 16 * db + 4 * fq) = w; }
    }
}

__device__ __forceinline__ void swa_qblock2(LAS const unsigned char* Kl, LAS const unsigned char* Vl, int kb_lo, const bf16_t* qptr, bf16_t* optr,
                                            int qi, int jmin, float sinkA, float sinkB, int lane) {
    const int fr = lane & 15, fq = lane >> 4;
    bf16x8 qf[2][2];
#pragma unroll
    for (int h2 = 0; h2 < 2; ++h2) { qf[h2][0] = __builtin_nontemporal_load((const bf16x8*)(qptr + 64 * h2 + 8 * fq)); qf[h2][1] = __builtin_nontemporal_load((const bf16x8*)(qptr + 64 * h2 + 32 + 8 * fq)); }
    f32x4 s[2][10];
    LAS const unsigned char* kbase = Kl + (kb_lo * 16 + fr) * KS64 + fq * 16;
#pragma unroll
    for (int i = 0; i < 10; ++i) {
        f32x4 a0 = {0.f, 0.f, 0.f, 0.f}, a1 = {0.f, 0.f, 0.f, 0.f};
#pragma unroll
        for (int ks = 0; ks < 2; ++ks) { const bf16x8 kf = *(LAS const bf16x8*)(kbase + i * 16 * KS64 + ks * 64);
            a0 = __builtin_amdgcn_mfma_f32_16x16x32_bf16(kf, qf[0][ks], a0, 0, 0, 0); a1 = __builtin_amdgcn_mfma_f32_16x16x32_bf16(kf, qf[1][ks], a1, 0, 0, 0); }
        s[0][i] = a0; s[1][i] = a1;
        if (i & 1) __builtin_amdgcn_sched_barrier(0);
    }
    const int jb = kb_lo * 16 + 4 * fq;
    float inv[2];
#pragma unroll
    for (int h2 = 0; h2 < 2; ++h2) {
        const float sink2 = h2 ? sinkB : sinkA;
        float mx = sink2;
#pragma unroll
        for (int i = 0; i < 10; ++i)
#pragma unroll
            for (int e = 0; e < 4; ++e) { const int j = jb + 16 * i + e; const bool ok = (j > qi) && (j <= qi + 128) && (j >= jmin); const float v = ok ? s[h2][i][e] : -1e30f; s[h2][i][e] = v; mx = fmaxf(mx, v); }
        mx = fmaxf(mx, __shfl_xor(mx, 16)); mx = fmaxf(mx, __shfl_xor(mx, 32));
        float sum = 0.f;
#pragma unroll
        for (int i = 0; i < 10; ++i)
#pragma unroll
            for (int e = 0; e < 4; ++e) { const float p = ex2(s[h2][i][e] - mx); s[h2][i][e] = p; sum += p; }
        sum += __shfl_xor(sum, 16); sum += __shfl_xor(sum, 32);
        sum += ex2(sink2 - mx);
        inv[h2] = __builtin_amdgcn_rcpf(sum);
    }
    f32x4 o[2][4];
#pragma unroll
    for (int h2 = 0; h2 < 2; ++h2)
#pragma unroll
        for (int d = 0; d < 4; ++d) o[h2][d] = (f32x4){0.f, 0.f, 0.f, 0.f};
    LAS const unsigned char* vbase = Vl + (kb_lo * 16 + 4 * fq + (fr >> 2)) * KS64 + (fr & 3) * 8;
#pragma unroll
    for (int g = 0; g < 5; ++g) {
        const bf16x8 pf0 = as_bf16x8(pack8(s[0][2 * g] * inv[0], s[0][2 * g + 1] * inv[0])), pf1 = as_bf16x8(pack8(s[1][2 * g] * inv[1], s[1][2 * g + 1] * inv[1]));
#pragma unroll
        for (int db = 0; db < 4; ++db) {
            const bf16x4 v0 = trread(vbase + (2 * g) * 16 * KS64 + db * 32), v1 = trread(vbase + (2 * g + 1) * 16 * KS64 + db * 32);
            const bf16x8 vf = cat4(v0, v1);
            o[0][db] = __builtin_amdgcn_mfma_f32_16x16x32_bf16(vf, pf0, o[0][db], 0, 0, 0); o[1][db] = __builtin_amdgcn_mfma_f32_16x16x32_bf16(vf, pf1, o[1][db], 0, 0, 0);
        }
        __builtin_amdgcn_sched_barrier(0);
    }
#pragma unroll
    for (int h2 = 0; h2 < 2; ++h2)
#pragma unroll
        for (int db = 0; db < 4; ++db) { u32x2 w; w.x = pk2(o[h2][db][0], o[h2][db][1]); w.y = pk2(o[h2][db][2], o[h2][db][3]); *(u32x2*)(optr + 64 * h2 + 16 * db + 4 * fq) = w; }
}

__device__ __forceinline__ void swa_prompt_item(const Params& P, LAS unsigned char* lds, int item) {
    unsigned char* ws = P.ws;
    const int tid = threadIdx.x, lane = tid & 63, wave = tid >> 6;
    const int kvh = item & 1, blk = (item >> 1) & 31, b = item >> 6;
    const bf16_t* ka = (const bf16_t*)(ws + WS_KA); const bf16_t* va = (const bf16_t*)(ws + WS_VA);
    LAS unsigned char* Kl = lds; LAS unsigned char* Vl = lds + 256 * KS64;
    __syncthreads();
#pragma unroll
    for (int i = 0; i < 4; ++i) {
        const int c = tid + i * NTHR, row = c >> 3, part = c & 7;
        u32x4 kv = {0u, 0u, 0u, 0u}, vv = {0u, 0u, 0u, 0u};
        if (blk > 0 || row >= 128) { const size_t t = (size_t)b * 4096 + (blk - 1) * 128 + row; kv = *(const u32x4*)(ka + t * 128 + kvh * 64 + part * 8); vv = *(const u32x4*)(va + t * 128 + kvh * 64 + part * 8); }
        *(LAS u32x4*)(Kl + row * KS64 + part * 16) = kv; *(LAS u32x4*)(Vl + row * KS64 + part * 16) = vv;
    }
    __syncthreads();
    const bf16_t* qa = (const bf16_t*)(ws + WS_QA); bf16_t* mix = (bf16_t*)(ws + WS_MIX);
    const int i_in = 16 * wave + (lane & 15);
    const size_t tok = (size_t)b * 4096 + blk * 128 + i_in;
    for (int hh = 0; hh < 4; hh += 2) {
        const int head = kvh * 4 + hh;
        swa_qblock2(Kl, Vl, wave & ~1, qa + tok * 512 + head * 64, mix + tok * 1024 + head * 64, i_in, blk == 0 ? 128 : 0, P.in[12][head] * LOG2E, P.in[12][head + 1] * LOG2E, lane);
    }
}

__device__ __forceinline__ void swa_sample_item(const Params& P, LAS unsigned char* lds, int item) {
    unsigned char* ws = P.ws;
    const int tid = threadIdx.x, lane = tid & 63, wave = tid >> 6;
    const int kvh = item & 1, bs = item >> 1;
    const bf16_t* ka = (const bf16_t*)(ws + WS_KA); const bf16_t* va = (const bf16_t*)(ws + WS_VA);
    const float* ck = P.in[3]; const float* cv = P.in[4];
    LAS unsigned char* Kl = lds; LAS unsigned char* Vl = lds + 256 * KS64;
    __syncthreads();
    for (int c = tid; c < 160 * 8; c += NTHR) {
        const int row = c >> 3, part = c & 7;
        u32x4 kv = {0u, 0u, 0u, 0u}, vv = {0u, 0u, 0u, 0u};
        if (row < 128) {
            const size_t src = ((size_t)(bs * 128 + row) * 2 + kvh) * 64 + part * 8;
            const f32x4 k0 = __builtin_nontemporal_load((const f32x4*)(ck + src)), k1 = __builtin_nontemporal_load((const f32x4*)(ck + src + 4)), v0 = __builtin_nontemporal_load((const f32x4*)(cv + src)), v1 = __builtin_nontemporal_load((const f32x4*)(cv + src + 4));
            kv = pack8(k0, k1); vv = pack8(v0, v1);
            if (row >= 8) { const size_t dst = ((size_t)(bs * 128 + row - 8) * 2 + kvh) * 64 + part * 8;
                __builtin_nontemporal_store(k0, (f32x4*)(P.out + O_SWAKS + dst)); __builtin_nontemporal_store(k1, (f32x4*)(P.out + O_SWAKS + dst + 4)); __builtin_nontemporal_store(v0, (f32x4*)(P.out + O_SWAVS + dst)); __builtin_nontemporal_store(v1, (f32x4*)(P.out + O_SWAVS + dst + 4)); }
        } else if (row < 136) {
            const size_t t = (size_t)TP + bs * 8 + (row - 128);
            kv = *(const u32x4*)(ka + t * 128 + kvh * 64 + part * 8); vv = *(const u32x4*)(va + t * 128 + kvh * 64 + part * 8);
        }
        *(LAS u32x4*)(Kl + row * KS64 + part * 16) = kv; *(LAS u32x4*)(Vl + row * KS64 + part * 16) = vv;
    }
    __syncthreads();
    if (wave < 2) {
        const bf16_t* qa = (const bf16_t*)(ws + WS_QA); bf16_t* mix = (bf16_t*)(ws + WS_MIX);
        const int ridx = 16 * wave + (lane & 15), hh = ridx >> 3, t = ridx & 7, head = kvh * 4 + hh;
        const size_t tok = (size_t)TP + bs * 8 + t;
        swa_qblock(Kl, Vl, 0, qa + tok * 512 + head * 64, mix + tok * 1024 + head * 64, true, t, 0, P.in[12][head] * LOG2E, lane);
    }
}

__device__ __forceinline__ float log2gamma(int h) { return __log2f(1.0f - exp2f(-5.0f - (float)h)); }

__device__ __forceinline__ void ret_local_item(const Params& P, LAS unsigned char* lds, int item) {
    unsigned char* ws = P.ws;
    const int tid = threadIdx.x, lane = tid & 63, wave = tid >> 6, fr = lane & 15, fq = lane >> 4;
    const int c = item & 31, h = (item >> 5) & 7, b = item >> 8;
    const bf16_t* kr = (const bf16_t*)(ws + WS_KR); const bf16_t* vr = (const bf16_t*)(ws + WS_VR);
    LAS unsigned char* Kl = lds; LAS unsigned char* Vl = lds + 128 * KS64;
    const float l2g = log2gamma(h);
    __syncthreads();
#pragma unroll
    for (int i = 0; i < 2; ++i) {
        const int cc = tid + i * NTHR, row = cc >> 3, part = cc & 7;
        const size_t t = (size_t)b * 4096 + c * 128 + row;
        const u32x4 kv = *(const u32x4*)(kr + t * 512 + h * 64 + part * 8), vv = *(const u32x4*)(vr + t * 512 + h * 64 + part * 8);
        const float dk = ex2((float)(127 - row) * l2g);
        u32x4 kd; kd.x = pk2(bflo(kv.x) * dk, bfhi(kv.x) * dk); kd.y = pk2(bflo(kv.y) * dk, bfhi(kv.y) * dk); kd.z = pk2(bflo(kv.z) * dk, bfhi(kv.z) * dk); kd.w = pk2(bflo(kv.w) * dk, bfhi(kv.w) * dk);
        *(LAS u32x4*)(Kl + row * KS64 + part * 16) = kd; *(LAS u32x4*)(Vl + row * KS64 + part * 16) = vv;
    }
    __syncthreads();
    const int eb = wave >> 1;
    f32x4 acc[2] = {{0.f, 0.f, 0.f, 0.f}, {0.f, 0.f, 0.f, 0.f}};
    LAS const unsigned char* vb = Vl + (8 * fq + (fr >> 2)) * KS64 + eb * 32 + (fr & 3) * 8;
    LAS const unsigned char* kb = Kl + (8 * fq + (fr >> 2)) * KS64 + (fr & 3) * 8;
#pragma unroll
    for (int ks = 0; ks < 4; ++ks) {
        const bf16x8 af = cat4(trread(vb + ks * 32 * KS64), trread(vb + ks * 32 * KS64 + 4 * KS64));
#pragma unroll
        for (int dd = 0; dd < 2; ++dd) {
            const int db = 2 * (wave & 1) + dd;
            const bf16x8 bfm = cat4(trread(kb + ks * 32 * KS64 + db * 32), trread(kb + ks * 32 * KS64 + 4 * KS64 + db * 32));
            acc[dd] = __builtin_amdgcn_mfma_f32_16x16x32_bf16(af, bfm, acc[dd], 0, 0, 0);
        }
    }
    float* kvl = (float*)(ws + WS_KVLOC) + (size_t)item * 4096;
#pragma unroll
    for (int dd = 0; dd < 2; ++dd) {
        const int db = 2 * (wave & 1) + dd;
#pragma unroll
        for (int e = 0; e < 4; ++e) kvl[(16 * eb + 4 * fq + e) * 64 + 16 * db + fr] = acc[dd][e];
    }
}

__device__ __forceinline__ void ret_sample_item(const Params& P, LAS unsigned char* lds, int item) {
    unsigned char* ws = P.ws;
    const int tid = threadIdx.x, lane = tid & 63, wave = tid >> 6;
    const int h = item & 7, bs = item >> 3;
    LAS float* ql = (LAS float*)lds; LAS float* kl = ql + 512; LAS float* vl = kl + 512; LAS float* al = vl + 512; LAS float* part = al + 64;
    const float l2g = log2gamma(h);
    __syncthreads();
    {
        const int t = tid >> 6, d = tid & 63; const size_t tok = (size_t)TP + bs * 8 + t;
        ql[tid] = bf2f(((const bf16_t*)(ws + WS_QR))[tok * 512 + h * 64 + d]);
        kl[tid] = bf2f(((const bf16_t*)(ws + WS_KR))[tok * 512 + h * 64 + d]);
        vl[tid] = bf2f(((const bf16_t*)(ws + WS_VR))[tok * 512 + h * 64 + d]);
    }
    __syncthreads();
    if (tid < 64) { const int i = tid >> 3, j = tid & 7; float a = 0.f; for (int d = 0; d < 64; ++d) a += ql[i * 64 + d] * kl[j * 64 + d]; al[tid] = (j <= i) ? a * ex2((float)(i - j) * l2g) : 0.f; }
    const int e = tid & 63, dg = tid >> 6;
    const float* s0p = P.in[5] + ((size_t)(bs * 8 + h) * 64 + dg * 8) * 64 + e;
    float* snp = P.out + O_RETS + ((size_t)(bs * 8 + h) * 64 + dg * 8) * 64 + e;
    float s0[8];
#pragma unroll
    for (int dd = 0; dd < 8; ++dd) s0[dd] = __builtin_nontemporal_load(s0p + dd * 64);
    const float g8 = ex2(8.0f * l2g);
#pragma unroll
    for (int dd = 0; dd < 8; ++dd) {
        float a = s0[dd] * g8;
#pragma unroll
        for (int j = 0; j < 8; ++j) a += ex2((float)(7 - j) * l2g) * kl[j * 64 + dg * 8 + dd] * vl[j * 64 + e];
        __builtin_nontemporal_store(a, snp + dd * 64);
    }
#pragma unroll
    for (int i = 0; i < 8; ++i) {
        float a = 0.f;
#pragma unroll
        for (int dd = 0; dd < 8; ++dd) a += ql[i * 64 + dg * 8 + dd] * s0[dd];
        part[(dg * 8 + i) * 64 + e] = a;
    }
    __syncthreads();
    {
        const int i = wave;
        float o = 0.f;
#pragma unroll
        for (int g = 0; g < 8; ++g) o += part[(g * 8 + i) * 64 + e];
        o *= ex2((float)(i + 1) * l2g);
#pragma unroll
        for (int j = 0; j < 8; ++j) o += al[i * 8 + j] * vl[j * 64 + e];
        float ss = o * o;
#pragma unroll
        for (int x = 1; x < 64; x <<= 1) ss += __shfl_xor(ss, x);
        const float rn = __builtin_amdgcn_rsqf(ss * (1.0f / 64.0f) + EPS);
        const size_t tok = (size_t)TP + bs * 8 + i;
        const float gate = bf2f(((const bf16_t*)(ws + WS_GS))[tok * 512 + h * 64 + e]);
        ((bf16_t*)(ws + WS_MIX))[tok * 1024 + 512 + h * 64 + e] = (bf16_t)(pk2(o * rn * gate, 0.f) & 0xffffu);
    }
}

__device__ __forceinline__ void memk_item(const Params& P, int item) {
    unsigned char* ws = P.ws;
    const int tid = threadIdx.x, lane = tid & 63, wave = tid >> 6;
    const float* gk = P.in[19]; const float* gq = P.in[18];
#pragma unroll
    for (int i = 0; i < 4; ++i) {
        const int pair = item * 32 + wave * 4 + i;
        float* p = P.out + O_MEMKP + (size_t)pair * 128 + 2 * lane;
        f32x2 v = *(f32x2*)p;
        float ss = v[0] * v[0] + v[1] * v[1];
#pragma unroll
        for (int x = 1; x < 64; x <<= 1) ss += __shfl_xor(ss, x);
        const float rn = __builtin_amdgcn_rsqf(ss * (1.0f / 128.0f) + EPS);
        v[0] = v[0] * rn * gk[2 * lane]; v[1] = v[1] * rn * gk[2 * lane + 1];
        __builtin_nontemporal_store(v, (f32x2*)p);
        ((unsigned*)(ws + WS_MKB))[(size_t)pair * 64 + lane] = pk2(v[0] * gq[2 * lane], v[1] * gq[2 * lane + 1]);
    }
}

__device__ __forceinline__ void phase2(const Params& P, LAS unsigned char* lds) {
    for (int it = blockIdx.x; it < 4096; it += gridDim.x) {
        if (it < 512) swa_prompt_item(P, lds, gridDim.x == 256 ? (it & 256) + (it & 7) * 32 + ((it & 255) >> 3) : it);
        else if (it < 768) swa_sample_item(P, lds, it - 512);
        else if (it < 2816) ret_local_item(P, lds, it - 768);
        else if (it < 3840) ret_sample_item(P, lds, it - 2816);
        else memk_item(P, it - 3840);
    }
}

__device__ __forceinline__ void phase3(const Params& P, int wg, int nwg) {
    unsigned char* ws = P.ws;
    const float* kvl = (const float*)(ws + WS_KVLOC); bf16_t* st = (bf16_t*)(ws + WS_ST);
    for (int el = wg * NTHR + threadIdx.x; el < 64 * 4096; el += nwg * NTHR) {
        const int bh = el >> 12, idx = el & 4095, e = idx >> 6, d = idx & 63, h = bh & 7;
        const float g128 = ex2(128.0f * log2gamma(h));
        float S = 0.f;
#pragma unroll 8
        for (int c = 0; c < 32; ++c) {
            const size_t o = ((size_t)(bh * 32 + c)) * 4096 + idx;
            st[o] = (bf16_t)(pk2(S, 0.f) & 0xffffu);
            S = S * g128 + __builtin_nontemporal_load(kvl + o);
        }
        P.out[O_RETP + ((size_t)bh * 64 + d) * 64 + e] = S;
    }
}

__device__ __forceinline__ void ret_out_item(const Params& P, LAS unsigned char* lds, int item) {
    unsigned char* ws = P.ws;
    const int tid = threadIdx.x, lane = tid & 63, wave = tid >> 6, fr = lane & 15, fq = lane >> 4;
    const int c = item & 31, h = (item >> 5) & 7, b = item >> 8;
    const bf16_t* qr = (const bf16_t*)(ws + WS_QR); const bf16_t* kr = (const bf16_t*)(ws + WS_KR); const bf16_t* vr = (const bf16_t*)(ws + WS_VR);
    LAS unsigned char* Kl = lds; LAS unsigned char* Vl = lds + 128 * KS64; LAS unsigned char* Sl = Vl + 128 * KS64;
    const float l2g = log2gamma(h);
    __syncthreads();
#pragma unroll
    for (int i = 0; i < 2; ++i) {
        const int cc = tid + i * NTHR, row = cc >> 3, part = cc & 7;
        const size_t t = (size_t)b * 4096 + c * 128 + row;
        *(LAS u32x4*)(Kl + row * KS64 + part * 16) = __builtin_nontemporal_load((const u32x4*)(kr + t * 512 + h * 64 + part * 8));
        *(LAS u32x4*)(Vl + row * KS64 + part * 16) = __builtin_nontemporal_load((const u32x4*)(vr + t * 512 + h * 64 + part * 8));
    }
    { const int row = tid >> 3, part = tid & 7; *(LAS u32x4*)(Sl + row * KS64 + part * 16) = __builtin_nontemporal_load((const u32x4*)((const bf16_t*)(ws + WS_ST) + (size_t)item * 4096 + row * 64 + part * 8)); }
    __syncthreads();
    const int i_in = 16 * wave + fr;
    const size_t tok = (size_t)b * 4096 + c * 128 + i_in;
    const bf16_t* qptr = qr + tok * 512 + h * 64;
    bf16x8 qf[2]; qf[0] = __builtin_nontemporal_load((const bf16x8*)(qptr + 8 * fq)); qf[1] = __builtin_nontemporal_load((const bf16x8*)(qptr + 32 + 8 * fq));
    f32x4 s[8];
    LAS const unsigned char* kbase = Kl + fr * KS64 + fq * 16;
#pragma unroll
    for (int kb = 0; kb < 8; ++kb) {
        f32x4 a = {0.f, 0.f, 0.f, 0.f};
        if (kb <= wave) {
#pragma unroll
            for (int ks = 0; ks < 2; ++ks) { const bf16x8 kf = *(LAS const bf16x8*)(kbase + kb * 16 * KS64 + ks * 64); a = __builtin_amdgcn_mfma_f32_16x16x32_bf16(kf, qf[ks], a, 0, 0, 0); }
#pragma unroll
            for (int e = 0; e < 4; ++e) { const int diff = i_in - (16 * kb + 4 * fq + e); a[e] = diff >= 0 ? a[e] * ex2((float)diff * l2g) : 0.f; }
        }
        s[kb] = a;
    }
    f32x4 o[4], oc[4];
#pragma unroll
    for (int d = 0; d < 4; ++d) { o[d] = (f32x4){0.f, 0.f, 0.f, 0.f}; oc[d] = (f32x4){0.f, 0.f, 0.f, 0.f}; }
    LAS const unsigned char* vbase = Vl + (4 * fq + (fr >> 2)) * KS64 + (fr & 3) * 8;
#pragma unroll
    for (int g = 0; g < 4; ++g) {
        if (2 * g <= wave) {
            const bf16x8 pf = as_bf16x8(pack8(s[2 * g], s[2 * g + 1]));
#pragma unroll
            for (int db = 0; db < 4; ++db) {
                const bf16x4 v0 = trread(vbase + (2 * g) * 16 * KS64 + db * 32), v1 = trread(vbase + (2 * g + 1) * 16 * KS64 + db * 32);
                o[db] = __builtin_amdgcn_mfma_f32_16x16x32_bf16(cat4(v0, v1), pf, o[db], 0, 0, 0);
            }
        }
    }
    LAS const unsigned char* sbase = Sl + fr * KS64 + fq * 16;
#pragma unroll
    for (int db = 0; db < 4; ++db)
#pragma unroll
        for (int ks = 0; ks < 2; ++ks) { const bf16x8 sf = *(LAS const bf16x8*)(sbase + db * 16 * KS64 + ks * 64); oc[db] = __builtin_amdgcn_mfma_f32_16x16x32_bf16(sf, qf[ks], oc[db], 0, 0, 0); }
    const float qd = ex2((float)(i_in + 1) * l2g);
    float ss = 0.f;
#pragma unroll
    for (int db = 0; db < 4; ++db) { o[db] = o[db] + oc[db] * qd; ss += dot4(o[db]); }
    ss += __shfl_xor(ss, 16); ss += __shfl_xor(ss, 32);
    const float rn = __builtin_amdgcn_rsqf(ss * (1.0f / 64.0f) + EPS);
    const bf16_t* gp = (const bf16_t*)(ws + WS_GS) + tok * 512 + h * 64 + 4 * fq;
    bf16_t* op = (bf16_t*)(ws + WS_MIX) + tok * 1024 + 512 + h * 64 + 4 * fq;
#pragma unroll
    for (int db = 0; db < 4; ++db) {
        const u32x2 gw = __builtin_nontemporal_load((const u32x2*)(gp + 16 * db));
        u32x2 w; w.x = pk2(o[db][0] * rn * bflo(gw.x), o[db][1] * rn * bfhi(gw.x)); w.y = pk2(o[db][2] * rn * bflo(gw.y), o[db][3] * rn * bfhi(gw.y));
        *(u32x2*)(op + 16 * db) = w;
    }
}
__device__ __forceinline__ void phase4(const Params& P, LAS unsigned char* lds, int first, int stride, int last) {
    for (int it = first; it < last; it += stride) ret_out_item(P, lds, it);
}

__device__ __forceinline__ void mem_qblock(LAS const unsigned char* Kl, LAS const unsigned char* Vl, const bf16_t* qptr, float sc, bf16_t* optr, bool do_store, int lane) {
    const int fr = lane & 15, fq = lane >> 4;
    bf16x8 qf[4];
#pragma unroll
    for (int ks = 0; ks < 4; ++ks) qf[ks] = __builtin_nontemporal_load((const bf16x8*)(qptr + 32 * ks + 8 * fq));
    f32x4 s[16];
    LAS const unsigned char* kbase = Kl + fr * KS128 + fq * 16;
#pragma unroll
    for (int i = 0; i < 16; ++i) {
        f32x4 a = {0.f, 0.f, 0.f, 0.f};
#pragma unroll
        for (int ks = 0; ks < 4; ++ks) { const bf16x8 kf = *(LAS const bf16x8*)(kbase + i * 16 * KS128 + ks * 64); a = __builtin_amdgcn_mfma_f32_16x16x32_bf16(kf, qf[ks], a, 0, 0, 0); }
        s[i] = a * sc;
        if (i & 1) __builtin_amdgcn_sched_barrier(0);
    }
    float mx = -1e30f;
#pragma unroll
    for (int i = 0; i < 16; ++i) mx = fmaxf(fmaxf(mx, fmaxf(s[i][0], s[i][1])), fmaxf(s[i][2], s[i][3]));
    mx = fmaxf(mx, __shfl_xor(mx, 16)); mx = fmaxf(mx, __shfl_xor(mx, 32));
    float sum = 0.f;
#pragma unroll
    for (int i = 0; i < 16; ++i)
#pragma unroll
        for (int e = 0; e < 4; ++e) { const float p = ex2(s[i][e] - mx); s[i][e] = p; sum += p; }
    sum += __shfl_xor(sum, 16); sum += __shfl_xor(sum, 32);
    const float inv = __builtin_amdgcn_rcpf(sum);
    f32x4 o[8];
#pragma unroll
    for (int d = 0; d < 8; ++d) o[d] = (f32x4){0.f, 0.f, 0.f, 0.f};
    LAS const unsigned char* vbase = Vl + (4 * fq + (fr >> 2)) * KS128 + (fr & 3) * 8;
#pragma unroll
    for (int g = 0; g < 8; ++g) {
        const bf16x8 pf = as_bf16x8(pack8(s[2 * g] * inv, s[2 * g + 1] * inv));
#pragma unroll
        for (int db = 0; db < 8; ++db) {
            const bf16x4 v0 = trread(vbase + (2 * g) * 16 * KS128 + db * 32), v1 = trread(vbase + (2 * g + 1) * 16 * KS128 + db * 32);
            o[db] = __builtin_amdgcn_mfma_f32_16x16x32_bf16(cat4(v0, v1), pf, o[db], 0, 0, 0);
        }
        __builtin_amdgcn_sched_barrier(0);
    }
    if (do_store) {
#pragma unroll
        for (int db = 0; db < 8; ++db) { u32x2 w; w.x = pk2(o[db][0], o[db][1]); w.y = pk2(o[db][2], o[db][3]); *(u32x2*)(optr + 16 * db + 4 * fq) = w; }
    }
}
constexpr float MEM_SC = 0.08838834764831845f * LOG2E;

__device__ __forceinline__ void mem_prompt_item(const Params& P, LAS unsigned char* lds, int item) {
    unsigned char* ws = P.ws;
    const int tid = threadIdx.x, lane = tid & 63, wave = tid >> 6;
    const int qt = item & 7, h = (item >> 3) & 3, b = item >> 5;
    const bf16_t* mkb = (const bf16_t*)(ws + WS_MKB); const bf16_t* mvb = (const bf16_t*)(ws + WS_MVB);
    LAS unsigned char* Kl = lds; LAS unsigned char* Vl = lds + 256 * KS128;
    __syncthreads();
#pragma unroll
    for (int i = 0; i < 8; ++i) {
        const int cc = tid + i * NTHR, row = cc >> 4, part = cc & 15;
        const size_t src = ((size_t)(b * 256 + row)) * 512 + h * 128 + part * 8;
        *(LAS u32x4*)(Kl + row * KS128 + part * 16) = *(const u32x4*)(mkb + src);
        *(LAS u32x4*)(Vl + row * KS128 + part * 16) = *(const u32x4*)(mvb + src);
    }
    __syncthreads();
    const bf16_t* qm = (const bf16_t*)(ws + WS_QM); const float* ssqm = (const float*)(ws + WS_SSQM); bf16_t* om = (bf16_t*)(ws + WS_OM);
    for (int qq = 0; qq < 4; ++qq) {
        const size_t tok = (size_t)b * 4096 + qt * 512 + (qq * 8 + wave) * 16 + (lane & 15);
        const float rq = __builtin_amdgcn_rsqf((ssqm[(size_t)(2 * h) * TT + tok] + ssqm[(size_t)(2 * h + 1) * TT + tok]) * (1.0f / 128.0f) + EPS);
        mem_qblock(Kl, Vl, qm + tok * 512 + h * 128, rq * MEM_SC, om + tok * 512 + h * 128, true, lane);
    }
}
__device__ __forceinline__ void mem_sample_item(const Params& P, LAS unsigned char* lds, int item) {
    unsigned char* ws = P.ws;
    const int tid = threadIdx.x, lane = tid & 63, wave = tid >> 6;
    const int h = item & 3, bs = item >> 2;
    const float* ck = P.in[6]; const float* cv = P.in[7]; const float* gq = P.in[18];
    LAS unsigned char* Kl = lds; LAS unsigned char* Vl = lds + 256 * KS128;
    __syncthreads();
    {
        const int part = tid & 15;
        const f32x4 g0 = *(const f32x4*)(gq + part * 8), g1 = *(const f32x4*)(gq + part * 8 + 4);
#pragma unroll
        for (int i = 0; i < 8; ++i) {
            const int row = (tid >> 4) + i * 32;
            const size_t src = ((size_t)(bs * 256 + row) * 4 + h) * 128 + part * 8;
            const f32x4 k0 = __builtin_nontemporal_load((const f32x4*)(ck + src)), k1 = __builtin_nontemporal_load((const f32x4*)(ck + src + 4)), v0 = __builtin_nontemporal_load((const f32x4*)(cv + src)), v1 = __builtin_nontemporal_load((const f32x4*)(cv + src + 4));
            *(LAS u32x4*)(Kl + row * KS128 + part * 16) = pack8(k0 * g0, k1 * g1);
            *(LAS u32x4*)(Vl + row * KS128 + part * 16) = pack8(v0, v1);
        }
    }
    __syncthreads();
    if (wave == 0) {
        const bf16_t* qm = (const bf16_t*)(ws + WS_QM); const float* ssqm = (const float*)(ws + WS_SSQM); bf16_t* om = (bf16_t*)(ws + WS_OM);
        const int r = lane & 15;
        const size_t tok = (size_t)TP + bs * 8 + (r & 7);
        const float rq = __builtin_amdgcn_rsqf((ssqm[(size_t)(2 * h) * TT + tok] + ssqm[(size_t)(2 * h + 1) * TT + tok]) * (1.0f / 128.0f) + EPS);
        mem_qblock(Kl, Vl, qm + tok * 512 + h * 128, rq * MEM_SC, om + tok * 512 + h * 128, r < 8, lane);
    }
}
__device__ __forceinline__ void phase7(const Params& P, LAS unsigned char* lds) {
    for (int it = blockIdx.x; it < 768; it += gridDim.x) {
        if (it < 256) mem_prompt_item(P, lds, gridDim.x == 256 ? (it & 7) * 32 + (it >> 3) : it);
        else mem_sample_item(P, lds, it - 256);
    }
}


#define XB_TMO      128
#define XB_XCNT(j)  (256  + 64 * (j))
#define XB_XSUB(j)  (1280 + 64 * (j))
#define XB_XGEN(j)  (2304 + 64 * (j))
#define XB_TOP      3328
#define XB_TOPGEN   3392
#define XCD_BAR_WORDS 3456
#define XB_SPIN_CAP (1u << 18)
constexpr size_t WS_BAR = WS_END + 4096;
__device__ __forceinline__ unsigned xb_ld(unsigned* p)              { return __hip_atomic_load(p, __ATOMIC_RELAXED, __HIP_MEMORY_SCOPE_AGENT); }
__device__ __forceinline__ unsigned xb_add(unsigned* p, unsigned v) { return __hip_atomic_fetch_add(p, v, __ATOMIC_RELAXED, __HIP_MEMORY_SCOPE_AGENT); }
__device__ __forceinline__ unsigned xb_xcc_id() { return (unsigned)__builtin_amdgcn_s_getreg((3 << 11) | 20) & 0xFu; }
#define XB_SPIN(cond, bar) do { unsigned _sp = 0; while (cond) { __builtin_amdgcn_s_sleep(1); \
    if ((++_sp & 255u) == 0u) { if (xb_ld(&(bar)[XB_TMO])) break; if (_sp > XB_SPIN_CAP) { atomicAdd(&(bar)[XB_TMO], 1u); break; } } } } while (0)
struct XcdBarrier { unsigned* bar; unsigned x; volatile LAS unsigned* st; };
__device__ __forceinline__ XcdBarrier xcd_barrier_post(unsigned* bar, volatile LAS unsigned* st) {
    XcdBarrier b; b.bar = bar; b.x = xb_xcc_id(); b.st = st;
    if (threadIdx.x == 0) (void)xb_add(&bar[XB_XCNT(b.x)], 1u);
    return b;
}
__device__ __forceinline__ void xcd_barrier_complete(unsigned* bar, unsigned x, unsigned& nloc, unsigned& nx) {
    const unsigned G = gridDim.x * gridDim.y * gridDim.z;
    unsigned sum, cnt, mine, sp = 0u;
    for (;;) {
        sum = 0u; cnt = 0u; mine = 0u;
#pragma unroll
        for (unsigned j = 0; j < 16; ++j) { const unsigned c = xb_ld(&bar[XB_XCNT(j)]); sum += c; cnt += (c > 0u) ? 1u : 0u; mine = (j == x) ? c : mine; }
        if (sum == G) break;
        __builtin_amdgcn_s_sleep(1);
        if ((++sp & 255u) == 0u) { if (xb_ld(&bar[XB_TMO])) break; if (sp > XB_SPIN_CAP) { atomicAdd(&bar[XB_TMO], 1u); break; } }
    }
    nloc = mine > 0u ? mine : 1u; nx = cnt > 0u ? cnt : 1u;
}
__device__ __forceinline__ void xcd_barrier(const XcdBarrier& b) {
    asm volatile("s_waitcnt vmcnt(0)" ::: "memory");
    __syncthreads();
    if (threadIdx.x == 0) {
        unsigned* bar = b.bar;
        __builtin_amdgcn_s_waitcnt(0);
        unsigned nloc = b.st[0], nx = b.st[1];
        if (nloc == 0u) { xcd_barrier_complete(bar, b.x, nloc, nx); b.st[0] = nloc; b.st[1] = nx; }
        const unsigned old = xb_add(&bar[XB_XSUB(b.x)], 1u);
        const unsigned gen = old / nloc;
        if (old + 1u == (gen + 1u) * nloc) {
            __builtin_amdgcn_fence(__ATOMIC_RELEASE, "agent");
            asm volatile("s_waitcnt vmcnt(0)" ::: "memory");
            const unsigned og = xb_add(&bar[XB_TOP], 1u);
            const unsigned tg = og / nx;
            if (og + 1u == (tg + 1u) * nx) xb_add(&bar[XB_TOPGEN], 1u);
            else XB_SPIN(xb_ld(&bar[XB_TOPGEN]) == tg, bar);
            __builtin_amdgcn_fence(__ATOMIC_ACQUIRE, "agent");
            xb_add(&bar[XB_XGEN(b.x)], 1u);
            asm volatile("s_waitcnt vmcnt(0)" ::: "memory");
        } else {
            XB_SPIN(xb_ld(&bar[XB_XGEN(b.x)]) == gen, bar);
            __builtin_amdgcn_fence(__ATOMIC_ACQUIRE, "agent");
            asm volatile("s_waitcnt vmcnt(0)" ::: "memory");
        }
    }
    __syncthreads();
}

__global__ void __launch_bounds__(NTHR) fwd_kernel(Params P) {
    __shared__ __attribute__((aligned(16))) unsigned char smem[LDS_BYTES];
    LAS unsigned char* lds = (LAS unsigned char*)smem;
    asm volatile("" : "+s"(lds));
    unsigned char* ws = P.ws;
    const int G = gridDim.x, cid = blockIdx.x;
#if ONE_LAUNCH
    cg::grid_group grid = cg::this_grid();
    if (P.hi > 1000) grid.sync();
    volatile LAS unsigned* bst = (volatile LAS unsigned*)(lds + LDS_BYTES - 16);
    if (threadIdx.x == 0) { bst[0] = 0u; bst[1] = 0u; }
    __syncthreads();
    const XcdBarrier xbar = xcd_barrier_post((unsigned*)(ws + WS_BAR), bst);
#define SEAM(k) do { if (P.lo <= (k) && (k) + 1 < P.hi) xcd_barrier(xbar); } while (0)
#else
#define SEAM(k) do { } while (0)
#endif
#ifndef PHMASK
#define PHMASK 0x7ff
#endif
#define IN(k) (((PHMASK >> (k)) & 1) && P.lo <= (k) && (k) < P.hi)
    if (IN(0)) { phase0(P); } SEAM(0);
    if (IN(1)) {
        pg8::Sched S; S.init(ws + WS_XB, ws + WS_WIN, TT, 2816, 1024, G, cid); S.extra(ws + WS_MEMB, ws + WS_WMKV, 2048, 1024);
        EpiA E{ws, P.in[10], P.in[11], P.out};
        pg8::gemm_phase<EpiA>(lds, 1024, S, E);
    } SEAM(1);
    if (IN(2)) { phase2(P, lds); } SEAM(2);
    const bool early = ONE_LAUNCH && G == 256 && P.lo == 0 && P.hi == 11;
    if (IN(3)) {
        if (early && cid >= 240) {
            const int u0 = cid - 240, pm = 128 + (u0 & 3), pn = u0 >> 2;
            SchedOne S1{(const char*)(ws + WS_MIX) + (size_t)pm * 256 * 1024 * 2, (const char*)(ws + WS_WOUT) + (size_t)pn * 256 * 1024 * 2, pm, pn, true};
            EpiRes<1> E{nullptr, nullptr, P.out, (bf16_t*)(ws + WS_XB), (float*)(ws + WS_SSQ1)};
            pg8::gemm_phase<EpiRes<1>, SchedOne>(lds, 1024, S1, E);
        } else phase3(P, cid, early ? 240 : G);
    } SEAM(3);
    if (IN(4)) {
        if (early && cid >= 248) {
            const int u0 = cid - 248, pm = 128 + (u0 & 3), pn = u0 >> 2;
            SchedOne S1{(const char*)(ws + WS_XB) + (size_t)pm * 256 * 1024 * 2, (const char*)(ws + WS_WMQ) + (size_t)pn * 256 * 1024 * 2, pm, pn, true};
            EpiMq E{(const float*)(ws + WS_SSQ1), (bf16_t*)(ws + WS_QM), (float*)(ws + WS_SSQM)};
            pg8::gemm_phase<EpiMq, SchedOne>(lds, 1024, S1, E);
            phase4(P, lds, 2024 + u0 * 3, 1, 2024 + u0 * 3 + 3);
        } else if (early) phase4(P, lds, cid, 248, 2024);
        else phase4(P, lds, cid, G, 2048);
        __syncthreads();
    } SEAM(4);
    if (IN(5)) {
        pg8::Sched S; S.init(ws + WS_MIX, ws + WS_WOUT, early ? TP : TT, 1024, 1024, G, cid);
        EpiRes<1> E{nullptr, nullptr, P.out, (bf16_t*)(ws + WS_XB), (float*)(ws + WS_SSQ1)};
        pg8::gemm_phase<EpiRes<1>>(lds, 1024, S, E);
    } SEAM(5);
    if (IN(6)) {
        pg8::Sched S; S.init(ws + WS_XB, ws + WS_WMQ, early ? TP : TT, 512, 1024, G, cid);
        EpiMq E{(const float*)(ws + WS_SSQ1), (bf16_t*)(ws + WS_QM), (float*)(ws + WS_SSQM)};
        pg8::gemm_phase<EpiMq>(lds, 1024, S, E);
    } SEAM(6);
    if (IN(7)) { phase7(P, lds); __syncthreads(); } SEAM(7);
    if (IN(8)) {
        pg8::Sched S; S.init(ws + WS_OM, ws + WS_WMO, TT, 1024, 512, G, cid);
        EpiRes<1> E{nullptr, nullptr, P.out, (bf16_t*)(ws + WS_XB), (float*)(ws + WS_SSQ2)};
        pg8::gemm_phase<EpiRes<1>>(lds, 512, S, E);
    } SEAM(8);
    unsigned* const hid_ready = (unsigned*)(ws + WS_BAR) + XCD_BAR_WORDS + 64;
    if (IN(9)) {
        SchedGu S; S.P.init(ws + WS_XB, ws + WS_WGU, TP, 5632, 1024, G, cid); S.G = G; S.c = cid; S.A = (const char*)(ws + WS_XB); S.B = (const char*)(ws + WS_WGU);
        EpiGu E{(const float*)(ws + WS_SSQ2), (bf16_t*)(ws + WS_HID), hid_ready};
        pg8::gemm_phase<EpiGu, SchedGu>(lds, 1024, S, E);
#if ONE_LAUNCH
        {
            const int u0 = (G == 256 && P.hi > 10) ? cid - 240 : -1;
            if (u0 >= 0 && u0 < 16) {
                if (threadIdx.x < 64) { unsigned sp = 0; while (__hip_atomic_load(hid_ready, __ATOMIC_RELAXED, __HIP_MEMORY_SCOPE_AGENT) < 704u && ++sp < (1u << 22)) __builtin_amdgcn_s_sleep(2);
                    __builtin_amdgcn_fence(__ATOMIC_ACQUIRE, "agent"); asm volatile("s_waitcnt vmcnt(0)" ::: "memory"); }
                __syncthreads();
                SchedDnTail ST{(const char*)(ws + WS_HID), (const char*)(ws + WS_WDN), u0};
                EpiRes<2> ET{nullptr, nullptr, P.out, (bf16_t*)(ws + WS_XB), nullptr};
                pg8::gemm_phase<EpiRes<2>, SchedDnTail>(lds, 2816, ST, ET);
            }
        }
#endif
    } SEAM(9);
    if (IN(10)) {
        const bool tail_done = ONE_LAUNCH && G == 256 && P.lo <= 9;
        pg8::Sched S; S.init(ws + WS_HID, ws + WS_WDN, tail_done ? TP : TT, 1024, 2816, G, cid);
        EpiRes<2> E{nullptr, nullptr, P.out, (bf16_t*)(ws + WS_XB), nullptr};
        pg8::gemm_phase<EpiRes<2>>(lds, 2816, S, E);
    }
}

extern "C" void kernel_launch(void* const* d_in, const int* in_sizes, int n_in, void* d_out, int out_size, void* d_ws, size_t ws_size, hipStream_t stream) {
    static int grid = 0;
    if (grid == 0) {
        if (n_in != 24 || (size_t)out_size != O_END || ws_size < WS_TOTAL) { fprintf(stderr, "kernel_launch: unexpected sizes n_in %d out %d (want %zu) ws %zu (want %zu)\n", n_in, out_size, (size_t)O_END, ws_size, (size_t)WS_END); grid = -1; return; }
        int dev = 0, cus = 0, per_cu = 0;
        hipGetDevice(&dev);
        hipDeviceGetAttribute(&cus, hipDeviceAttributeMultiprocessorCount, dev);
        hipOccupancyMaxActiveBlocksPerMultiprocessor(&per_cu, (const void*)fwd_kernel, NTHR, 0);
        if (per_cu < 1) { fprintf(stderr, "kernel_launch: occupancy query says %d blocks per CU\n", per_cu); per_cu = 1; }
        (void)hipGetLastError();
        grid = cus * per_cu;
    }
    if (grid < 0) return;
    Params p{};
    for (int i = 0; i < 24; ++i) p.in[i] = (const float*)d_in[i];
    p.out = (float*)d_out; p.ws = (unsigned char*)d_ws;
#if ONE_LAUNCH
    p.lo = 0; p.hi = 11;
    if (hipMemsetAsync((char*)d_ws + WS_BAR, 0, (XCD_BAR_WORDS + 128) * 4, stream) != hipSuccess) { fprintf(stderr, "kernel_launch: memset of barrier words failed\n"); return; }
    void* args[] = {&p};
    hipError_t e = hipLaunchCooperativeKernel((const void*)fwd_kernel, dim3(grid), dim3(NTHR), args, 0, stream);
    if (e != hipSuccess) fprintf(stderr, "cooperative launch failed: %s (grid %d)\n", hipGetErrorString(e), grid);
#else
    for (int ph = 0; ph < 11; ++ph) { p.lo = ph; p.hi = ph + 1; hipLaunchKernelGGL(fwd_kernel, dim3(grid), dim3(NTHR), 0, stream, p); }
#endif
}
```
